# Optimizing an MI355X kernel written in HIP

```python
import math
import jax, jax.numpy as jnp
from jax import lax
import numpy as np

D_MODEL = 2048
BATCH = 2
SEQ = 4096
DEPTH = 2

N_A_LAYERS = DEPTH // 2
N_B_LAYERS = DEPTH - N_A_LAYERS
D_FF = 5632
LRU_WIDTH = D_MODEL
LRU_HEADS = 8
LRU_BLOCK = LRU_WIDTH // LRU_HEADS
CONV_W = 4
LRU_C = 8.0
N_HEADS = 16
HEAD_DIM = D_MODEL // N_HEADS
MOBA_BLOCK = 256
MOBA_TOPK = 3
Q_CHUNK = 32
EPS = 1e-6

kernel_name = 'yoco_rglru_moba_macaron'


def _rms_norm(x, g):
    xf = x.astype(jnp.float32)
    y = xf * lax.rsqrt(jnp.mean(xf * xf, axis=-1, keepdims=True) + EPS)
    return (y * g.astype(jnp.float32)).astype(x.dtype)


def _swiglu(h, w_in, w_out):
    gate, up = jnp.split(h @ w_in, 2, axis=-1)
    return (jax.nn.silu(gate) * up) @ w_out


def _causal_depthwise_conv(x, w, b):
    seq = x.shape[1]
    xp = jnp.pad(x, ((0, 0), (CONV_W - 1, 0), (0, 0)))
    y = b
    for tap in range(CONV_W):
        y = y + xp[:, tap:tap + seq] * w[tap]
    return y


def _linear_scan_combine(left, right):
    a_l, u_l = left
    a_r, u_r = right
    return a_l * a_r, a_r * u_l + u_r


def _rglru_block(hn, w_in, conv_w, conv_b, gate_w, gate_b, lam, w_out):
    bsz, seq, _ = hn.shape
    xb, yb = jnp.split(hn @ w_in, 2, axis=-1)
    yb = jax.nn.gelu(yb, approximate=True)
    xb = _causal_depthwise_conv(xb, conv_w, conv_b)
    xh = xb.reshape(bsz, seq, LRU_HEADS, LRU_BLOCK)
    gates = jnp.einsum('bshi,ghij->gbshj', xh, gate_w).reshape(2, bsz, seq, LRU_WIDTH)
    gates = jax.nn.sigmoid(gates.astype(jnp.float32) + gate_b[:, None, None, :].astype(jnp.float32))
    r, i = gates[0], gates[1]
    log_a = -LRU_C * r * jax.nn.softplus(-lam.astype(jnp.float32))
    a = jnp.exp(log_a)
    mult = jnp.sqrt(-jnp.expm1(2.0 * log_a))
    u = xb.astype(jnp.float32) * i * mult
    _, hs = lax.associative_scan(_linear_scan_combine, (a, u), axis=1)
    return (hs.astype(hn.dtype) * yb) @ w_out


def _shared_kv(h, kv_norm_g, w_kv, k_norm_g):
    bsz, seq, _ = h.shape
    n_blocks = -(-seq // MOBA_BLOCK)
    pad = n_blocks * MOBA_BLOCK - seq
    kv = (_rms_norm(h, kv_norm_g) @ w_kv).reshape(bsz, seq, 2, N_HEADS, HEAD_DIM)
    k = _rms_norm(kv[:, :, 0], k_norm_g)
    v = kv[:, :, 1]

    def to_blocks(t):
        t = jnp.pad(t, ((0, 0), (0, pad), (0, 0), (0, 0)))
        return t.reshape(bsz, n_blocks, MOBA_BLOCK, N_HEADS, HEAD_DIM).transpose(0, 3, 1, 2, 4)

    kb, vb = to_blocks(k), to_blocks(v)
    k_mean = jnp.mean(kb.astype(jnp.float32), axis=3)
    return kb, vb, k_mean


def _moba_attention(q, kb, vb, k_mean):
    bsz, n_heads, seq, hd = q.shape
    n_blocks = kb.shape[2]
    k_sel = min(MOBA_TOPK, n_blocks)
    scale = hd ** -0.5
    b_idx = jnp.arange(bsz)[:, None, None, None]
    h_idx = jnp.arange(n_heads)[None, :, None, None]

    def chunk(c):
        start = c * Q_CHUNK
        own = start // MOBA_BLOCK
        qc = lax.dynamic_slice_in_dim(q, start, Q_CHUNK, axis=2)
        gate = jnp.einsum('bhqd,bhnd->bhqn', qc.astype(jnp.float32), k_mean)
        past = jnp.arange(n_blocks) < own
        gate = jnp.where(past, gate, -jnp.inf)
        _, sel = lax.top_k(gate, k_sel)
        valid = sel < own
        k_g = kb[b_idx, h_idx, sel]
        v_g = vb[b_idx, h_idx, sel]
        s_sel = jnp.einsum('bhqd,bhqnkd->bhqnk', qc, k_g).astype(jnp.float32) * scale
        s_sel = jnp.where(valid[..., None], s_sel, -jnp.inf)
        s_sel = s_sel.reshape(bsz, n_heads, Q_CHUNK, k_sel * MOBA_BLOCK)
        k_own = lax.dynamic_index_in_dim(kb, own, axis=2, keepdims=False)
        v_own = lax.dynamic_index_in_dim(vb, own, axis=2, keepdims=False)
        s_own = jnp.einsum('bhqd,bhkd->bhqk', qc, k_own).astype(jnp.float32) * scale
        q_pos = start + jnp.arange(Q_CHUNK)
        k_pos = own * MOBA_BLOCK + jnp.arange(MOBA_BLOCK)
        s_own = jnp.where(k_pos[None, :] <= q_pos[:, None], s_own, -jnp.inf)
        p = jax.nn.softmax(jnp.concatenate([s_sel, s_own], axis=-1), axis=-1).astype(q.dtype)
        p_sel = p[..., :k_sel * MOBA_BLOCK].reshape(bsz, n_heads, Q_CHUNK, k_sel, MOBA_BLOCK)
        p_own = p[..., k_sel * MOBA_BLOCK:]
        return (jnp.einsum('bhqnk,bhqnkd->bhqd', p_sel, v_g)
                + jnp.einsum('bhqk,bhkd->bhqd', p_own, v_own))

    out = lax.map(chunk, jnp.arange(seq // Q_CHUNK))
    return out.transpose(1, 2, 0, 3, 4).reshape(bsz, n_heads, seq, hd)


def _moba_block(hn, kb, vb, k_mean, w_q, q_g, w_o):
    bsz, seq, _ = hn.shape
    q = _rms_norm((hn @ w_q).reshape(bsz, seq, N_HEADS, HEAD_DIM), q_g).transpose(0, 2, 1, 3)
    o = _moba_attention(q, kb, vb, k_mean)
    return o.transpose(0, 2, 1, 3).reshape(bsz, seq, N_HEADS * HEAD_DIM) @ w_o


def setup_inputs(seed: int = 0) -> dict:
    key = jax.random.key(seed)
    ks = jax.random.split(key, 17)
    f32 = jnp.float32

    def nrm(k, shape, fan_in):
        return jax.random.normal(k, shape, f32) * (fan_in ** -0.5)

    u = jax.random.uniform(ks[9], (N_A_LAYERS, LRU_WIDTH), f32, minval=0.9, maxval=0.999)
    return {
        'x': jax.random.normal(ks[0], (BATCH, SEQ, D_MODEL), f32),
        'norm_g': 1.0 + 0.02 * jax.random.normal(ks[1], (DEPTH, 3, D_MODEL), f32),
        'ffn_w_in': nrm(ks[2], (DEPTH, 2, D_MODEL, 2 * D_FF), D_MODEL),
        'ffn_w_out': nrm(ks[3], (DEPTH, 2, D_FF, D_MODEL), D_FF),
        'lru_w_in': nrm(ks[4], (N_A_LAYERS, D_MODEL, 2 * LRU_WIDTH), D_MODEL),
        'lru_conv_w': nrm(ks[5], (N_A_LAYERS, CONV_W, LRU_WIDTH), CONV_W),
        'lru_conv_b': 0.01 * jax.random.normal(ks[6], (N_A_LAYERS, LRU_WIDTH), f32),
        'lru_gate_w': nrm(ks[7], (N_A_LAYERS, 2, LRU_HEADS, LRU_BLOCK, LRU_BLOCK), LRU_BLOCK),
        'lru_gate_b': 0.01 * jax.random.normal(ks[8], (N_A_LAYERS, 2, LRU_WIDTH), f32),
        'lru_lambda': jnp.log(u) - jnp.log1p(-u),
        'lru_w_out': nrm(ks[10], (N_A_LAYERS, LRU_WIDTH, D_MODEL), LRU_WIDTH),
        'kv_norm_g': 1.0 + 0.02 * jax.random.normal(ks[11], (D_MODEL,), f32),
        'w_kv': nrm(ks[12], (D_MODEL, 2 * N_HEADS * HEAD_DIM), D_MODEL),
        'k_norm_g': 1.0 + 0.02 * jax.random.normal(ks[13], (HEAD_DIM,), f32),
        'attn_w_q': nrm(ks[14], (N_B_LAYERS, D_MODEL, N_HEADS * HEAD_DIM), D_MODEL),
        'q_norm_g': 1.0 + 0.02 * jax.random.normal(ks[15], (N_B_LAYERS, HEAD_DIM), f32),
        'attn_w_o': nrm(ks[16], (N_B_LAYERS, N_HEADS * HEAD_DIM, D_MODEL), N_HEADS * HEAD_DIM),
    }


def reference(x, norm_g, ffn_w_in, ffn_w_out, lru_w_in, lru_conv_w, lru_conv_b, lru_gate_w,
              lru_gate_b, lru_lambda, lru_w_out, kv_norm_g, w_kv, k_norm_g, attn_w_q, q_norm_g,
              attn_w_o):
    h = x
    kb = vb = k_mean = None
    for layer in range(DEPTH):
        h = h + 0.5 * _swiglu(_rms_norm(h, norm_g[layer, 0]), ffn_w_in[layer, 0], ffn_w_out[layer, 0])
        if layer < N_A_LAYERS:
            a = layer
            h = h + _rglru_block(_rms_norm(h, norm_g[layer, 1]), lru_w_in[a], lru_conv_w[a],
                                 lru_conv_b[a], lru_gate_w[a], lru_gate_b[a], lru_lambda[a],
                                 lru_w_out[a])
        else:
            j = layer - N_A_LAYERS
            h = h + _moba_block(_rms_norm(h, norm_g[layer, 1]), kb, vb, k_mean,
                                attn_w_q[j], q_norm_g[j], attn_w_o[j])
        h = h + 0.5 * _swiglu(_rms_norm(h, norm_g[layer, 2]), ffn_w_in[layer, 1], ffn_w_out[layer, 1])
        if layer == N_A_LAYERS - 1:
            kb, vb, k_mean = _shared_kv(h, kv_norm_g, w_kv, k_norm_g)
    return h
```

```cpp
#include <hip/hip_runtime.h>
#include <hip/hip_cooperative_groups.h>
#include <cstdio>
#include <cstdint>
namespace cg = cooperative_groups;

#define LAS __attribute__((address_space(3)))
typedef unsigned short bf16;
typedef short bf16x8 __attribute__((ext_vector_type(8)));
typedef float f32x4 __attribute__((ext_vector_type(4)));
typedef float f32x16 __attribute__((ext_vector_type(16)));
typedef unsigned u32x4 __attribute__((ext_vector_type(4)));
typedef unsigned u32x2 __attribute__((ext_vector_type(2)));
typedef __bf16 bf16x2_t __attribute__((ext_vector_type(2)));
typedef float f32x2_t __attribute__((ext_vector_type(2)));

__device__ __forceinline__ unsigned pk2(float lo, float hi) { f32x2_t v = {lo, hi}; bf16x2_t b = __builtin_convertvector(v, bf16x2_t); return __builtin_bit_cast(unsigned, b); }
__device__ __forceinline__ float bflo(unsigned w) { return __uint_as_float(w << 16); }
__device__ __forceinline__ float bfhi(unsigned w) { return __uint_as_float(w & 0xffff0000u); }
__device__ __forceinline__ float wave_sum(float v) {
#pragma unroll
    for (int o = 1; o < 64; o <<= 1) v += __shfl_xor(v, o);
    return v;
}
__device__ __forceinline__ float sigmoidf_(float x) { return __builtin_amdgcn_rcpf(1.0f + __builtin_amdgcn_exp2f(-1.4426950408889634f * x)); }

constexpr int M = 8192, D = 2048, FF = 5632, SEQ = 4096, NH = 16, HD = 128;
constexpr float EPS = 1e-6f;

namespace pg8 {
constexpr int BM = 256, BK = 64, HALF = 128, HTB = HALF * BK * 2, STAGE_BYTES = 8 * HTB, NXCD = 8, WGM = 8;
__host__ __device__ __forceinline__ int lds_byte(int r, int c) { const int st = (r >> 4) * 2 + (c >> 5), rr = r & 15, cc = c & 31, ob = rr * 64 + cc * 2; return st * 1024 + (ob ^ (((ob >> 9) & 1) << 5)); }
__host__ __device__ __forceinline__ void stage_rc(int b, int& R, int& C) { const int st = b / 1024, sb = b % 1024, swz = sb ^ (((sb >> 9) & 1) << 5); R = (st >> 1) * 16 + swz / 64; C = (st & 1) * 32 + (swz % 64) / 2; }
__host__ __device__ __forceinline__ int perm32(int rho) { const int n = rho >> 4, i = rho & 15; return 8 * (i >> 2) + 4 * n + (i & 3); }

struct Unit { int pm, pn; };
struct Gemm { const bf16* A; const bf16* Bt; int M, N, K, lda, a_mask, a_stride; };

struct StaticOrder {
    int nM, nN, nwg, G, c;
    __device__ void init(int M_, int N_, int G_, int c_) { nM = M_ / BM; nN = N_ / BM; nwg = nM * nN; G = G_; c = c_; }
    __device__ bool next(int i, Unit& u) const {
        const long L = (long)i * G + c; if (L >= nwg) return false;
        int wgid = (int)L; { const int q = nwg / NXCD, r = nwg % NXCD, xcd = wgid % NXCD, off = wgid / NXCD; wgid = (xcd < r ? xcd * (q + 1) : r * (q + 1) + (xcd - r) * q) + off; }
        const int nig = WGM * nN, gid = wgid / nig, fm = gid * WGM, gsz = (nM - fm) < WGM ? (nM - fm) : WGM;
        u.pm = fm + ((wgid % nig) % gsz); u.pn = (wgid % nig) / gsz; return true;
    }
};


typedef unsigned long long u64;
constexpr float SS_SCALE = 16777216.0f;
__device__ __forceinline__ void ssum_prefetch(const u64* ssum, const Unit& u, int wr, int fr, float (&rp)[2][4]) {
#pragma unroll
    for (int ai = 0; ai < 2; ++ai)
#pragma unroll
        for (int m = 0; m < 4; ++m) rp[ai][m] = ssum ? (float)ssum[u.pm * BM + wr * 64 + fr + ai * HALF + m * 16] * (1.0f / SS_SCALE) : 0.f;
}
__device__ __forceinline__ float rinv_of(float ssum) { return rsqrtf(ssum * (1.0f / D) + EPS); }
struct EpiResid {
    static constexpr bool PERM = true;
    bf16* hb; u64* ss; float* outf; float scale;
    __device__ __forceinline__ void prefetch(const Unit&, int, int, float (&)[2][4]) const {}
    __device__ __forceinline__ void operator()(const f32x4 (&acc)[2][2][4][2], const Unit& u, int wr, int wc, int fr, int fq, const float (&rp)[2][4]) const {
        const int row0 = u.pm * BM + wr * 64 + fr, col0 = u.pn * BM + wc * 32 + 8 * fq;
#pragma unroll
        for (int ai = 0; ai < 2; ++ai)
#pragma unroll
            for (int m = 0; m < 4; ++m) { const int row = row0 + ai * HALF + m * 16; const size_t off = (size_t)row * D + col0; float sq = 0.f;
#pragma unroll
                for (int bj = 0; bj < 2; ++bj) { const u32x4 bw = *(const u32x4*)(hb + off + bj * HALF);
                    const f32x4 v0 = acc[ai][bj][m][0] * scale + (f32x4){bflo(bw.x), bfhi(bw.x), bflo(bw.y), bfhi(bw.y)};
                    const f32x4 v1 = acc[ai][bj][m][1] * scale + (f32x4){bflo(bw.z), bfhi(bw.z), bflo(bw.w), bfhi(bw.w)};
                    if (outf) { *(f32x4*)(outf + off + bj * HALF) = v0; *(f32x4*)(outf + off + bj * HALF + 4) = v1; }
                    else { u32x4 w; w.x = pk2(v0.x, v0.y); w.y = pk2(v0.z, v0.w); w.z = pk2(v1.x, v1.y); w.w = pk2(v1.z, v1.w); *(u32x4*)(hb + off + bj * HALF) = w;
                        sq += ((v0.x * v0.x + v0.y * v0.y) + (v0.z * v0.z + v0.w * v0.w)) + ((v1.x * v1.x + v1.y * v1.y) + (v1.z * v1.z + v1.w * v1.w)); } }
                if (!outf) { sq += __shfl_xor(sq, 16); sq += __shfl_xor(sq, 32); if (fq == 0) atomicAdd(ss + row, (u64)__float2ull_rn(sq * SS_SCALE)); } }
    }
};
struct EpiSwiGLU {
    static constexpr bool PERM = true;
    bf16* out; const u64* ss;
    __device__ __forceinline__ void prefetch(const Unit& u, int wr, int fr, float (&rp)[2][4]) const { ssum_prefetch(ss, u, wr, fr, rp); }
    __device__ __forceinline__ void operator()(const f32x4 (&acc)[2][2][4][2], const Unit& u, int wr, int wc, int fr, int fq, const float (&rp)[2][4]) const {
        const int row0 = u.pm * BM + wr * 64 + fr, col0 = u.pn * HALF + wc * 32 + 8 * fq;
#pragma unroll
        for (int ai = 0; ai < 2; ++ai)
#pragma unroll
            for (int m = 0; m < 4; ++m) { float o[8]; const float ri = rinv_of(rp[ai][m]);
#pragma unroll
                for (int n = 0; n < 2; ++n)
#pragma unroll
                    for (int j = 0; j < 4; ++j) { const float g = acc[ai][0][m][n][j] * ri, up = acc[ai][1][m][n][j] * ri; o[4 * n + j] = g * sigmoidf_(g) * up; }
                u32x4 w; w.x = pk2(o[0], o[1]); w.y = pk2(o[2], o[3]); w.z = pk2(o[4], o[5]); w.w = pk2(o[6], o[7]);
                *(u32x4*)(out + (size_t)(row0 + ai * HALF + m * 16) * FF + col0) = w; }
    }
};
struct EpiBf16 {
    static constexpr bool PERM = true;
    bf16* out; int ldc; int gelu_from; const u64* ss;
    __device__ __forceinline__ void prefetch(const Unit& u, int wr, int fr, float (&rp)[2][4]) const { ssum_prefetch(ss, u, wr, fr, rp); }
    __device__ __forceinline__ void operator()(const f32x4 (&acc)[2][2][4][2], const Unit& u, int wr, int wc, int fr, int fq, const float (&rp)[2][4]) const {
        const int row0 = u.pm * BM + wr * 64 + fr, col0 = u.pn * BM + wc * 32 + 8 * fq;
        const bool act = u.pn >= gelu_from;
#pragma unroll
        for (int ai = 0; ai < 2; ++ai)
#pragma unroll
            for (int m = 0; m < 4; ++m) { const float ri = ss ? rinv_of(rp[ai][m]) : 1.0f;
#pragma unroll
                for (int bj = 0; bj < 2; ++bj) { float o[8];
#pragma unroll
                    for (int n = 0; n < 2; ++n)
#pragma unroll
                        for (int j = 0; j < 4; ++j) { float v = acc[ai][bj][m][n][j] * ri;
                            if (act) { const float z = 0.7978845608f * (v + 0.044715f * v * v * v); v = v * sigmoidf_(2.0f * z); }
                            o[4 * n + j] = v; }
                    u32x4 w; w.x = pk2(o[0], o[1]); w.y = pk2(o[2], o[3]); w.z = pk2(o[4], o[5]); w.w = pk2(o[6], o[7]);
                    *(u32x4*)(out + (size_t)(row0 + ai * HALF + m * 16) * ldc + col0 + bj * HALF) = w; } }
    }
};

struct PairOrder { int pm, h; __device__ __forceinline__ bool next(int i, Unit& u) const { if (i >= 2) return false; int p = pm, n = h + 8 * i; asm volatile("" : "+s"(p), "+s"(n));
        u.pm = p; u.pn = n; return true; } };

template <class Epi, class Sched = StaticOrder>
__device__ __forceinline__ void gemm_phase(LAS unsigned char* lds, const Gemm g, const Sched& S, const Epi& E) {
    int tid = threadIdx.x; asm volatile("" : "+v"(tid));
    const int wid = __builtin_amdgcn_readfirstlane(tid >> 6), lane = tid & 63, wr = wid >> 2, wc = wid & 3, fr = lane & 15, fq = lane >> 4;
    const int K = g.K, nt = K / BK, lda = g.lda;
    unsigned voffA[2], voffB[2];
#pragma unroll
    for (int i = 0; i < 2; ++i) { int R, C; stage_rc(tid * 16 + i * 8192, R, C); const int Rb = Epi::PERM ? ((R & ~31) + perm32(R & 31)) : R;
        voffA[i] = (unsigned)(R * lda + C) * 2u; voffB[i] = (unsigned)(Rb * K + C) * 2u; }
    const size_t kstep = (size_t)(BK * 2);
    const size_t hstepA = (size_t)HALF * lda * 2, hstepB = (size_t)HALF * K * 2;
    const size_t tstepA = 2 * hstepA, tstepB = 2 * hstepB;
    const unsigned ldsw = (unsigned)wid * 1024u;
    const int aoff = lds_byte(wr * 64 + fr, fq * 8), boff = lds_byte(wc * 32 + fr, fq * 8);
#define PG8_SA(b, h) (((b) * 2 + (h)) * HTB)
#define PG8_SB(b, h) ((4 + (b) * 2 + (h)) * HTB)
#define PG8_STAGE(bufoff, gbase, voff) do { _Pragma("unroll") for (int _i = 0; _i < 2; ++_i) \
        __builtin_amdgcn_global_load_lds((const unsigned*)((const char*)(gbase) + (voff)[_i]), (LAS unsigned*)(lds + (bufoff) + ldsw + _i * 8192), 16, 0, 0); } while (0)
#define PG8_LDA(dst, b, h) do { _Pragma("unroll") for (int m = 0; m < 4; ++m) _Pragma("unroll") for (int k = 0; k < 2; ++k) dst[m][k] = *(const LAS bf16x8*)(lds + PG8_SA(b, h) + aoff + m * 2048 + k * 1024); } while (0)
#define PG8_LDB(dst, b, h) do { _Pragma("unroll") for (int n = 0; n < 2; ++n) _Pragma("unroll") for (int k = 0; k < 2; ++k) dst[n][k] = *(const LAS bf16x8*)(lds + PG8_SB(b, h) + boff + n * 2048 + k * 1024); } while (0)
#define PG8_MMA(ai, bj, At, Bt) do { __builtin_amdgcn_s_setprio(1); _Pragma("unroll") for (int m = 0; m < 4; ++m) _Pragma("unroll") for (int n = 0; n < 2; ++n) _Pragma("unroll") for (int k = 0; k < 2; ++k) \
        acc[ai][bj][m][n] = __builtin_amdgcn_mfma_f32_16x16x32_bf16(Bt[n][k], At[m][k], acc[ai][bj][m][n], 0, 0, 0); __builtin_amdgcn_s_setprio(0); } while (0)
#define PG8_WAIT_V(n) asm volatile("s_waitcnt vmcnt(" #n ")" ::: "memory")
#define PG8_WAIT_L(n) asm volatile("s_waitcnt lgkmcnt(" #n ")" ::: "memory")
#define PG8_BAR __builtin_amdgcn_s_barrier()
#define PG8_SCHED __builtin_amdgcn_sched_barrier(0)
    Unit cur, nxt; int ui = 0;
    if (!S.next(0, cur)) return;
    f32x4 acc[2][2][4][2];
#pragma unroll
    for (int a = 0; a < 2; ++a)
#pragma unroll
        for (int b = 0; b < 2; ++b)
#pragma unroll
            for (int m = 0; m < 4; ++m)
#pragma unroll
                for (int n = 0; n < 2; ++n) acc[a][b][m][n] = (f32x4){0.f, 0.f, 0.f, 0.f};
    bf16x8 At[4][2], B0[2][2], B1[2][2];
    float rpre[2][4];
    const char* cA = (const char*)g.A + (size_t)cur.pm * tstepA + (size_t)((cur.pn & g.a_mask) * g.a_stride) * 2; const char* cB = (const char*)g.Bt + (size_t)cur.pn * tstepB;
    PG8_STAGE(PG8_SB(0, 0), cB, voffB); PG8_STAGE(PG8_SB(0, 1), cB + hstepB, voffB); PG8_STAGE(PG8_SA(0, 0), cA, voffA); PG8_STAGE(PG8_SA(0, 1), cA + hstepA, voffA);
    if (wr == 1) PG8_BAR;
    PG8_WAIT_V(2); PG8_BAR;
    PG8_STAGE(PG8_SB(1, 0), cB + kstep, voffB); PG8_STAGE(PG8_SA(1, 0), cA + kstep, voffA); PG8_STAGE(PG8_SB(1, 1), cB + hstepB + kstep, voffB);
    PG8_WAIT_V(6); PG8_BAR;
    for (;;) {
        const bool has_next = S.next(ui + 1, nxt);
        const char* nA = has_next ? (const char*)g.A + (size_t)nxt.pm * tstepA + (size_t)((nxt.pn & g.a_mask) * g.a_stride) * 2 : cA; const char* nB = has_next ? (const char*)g.Bt + (size_t)nxt.pn * tstepB : cB;
        for (int t = 0; t < nt; t += 2) {
            const bool last = (t == nt - 2);
            const char* a1 = cA + (size_t)(t + 1) * kstep;
            const char* a2 = last ? nA : cA + (size_t)(t + 2) * kstep; const char* b2 = last ? nB : cB + (size_t)(t + 2) * kstep;
            const char* a3 = a2 + kstep; const char* b3 = b2 + kstep;
            if (last) E.prefetch(cur, wr, fr, rpre);
            PG8_STAGE(PG8_SA(1, 1), a1 + hstepA, voffA); PG8_SCHED; PG8_LDB(B0, 0, 0); PG8_LDB(B1, 0, 1); PG8_SCHED; PG8_LDA(At, 0, 0);
            PG8_WAIT_V(8); PG8_WAIT_L(0); PG8_BAR; PG8_MMA(0, 0, At, B0); PG8_MMA(0, 1, At, B1); PG8_BAR; PG8_SCHED;
            PG8_STAGE(PG8_SB(0, 0), b2, voffB); PG8_STAGE(PG8_SB(0, 1), b2 + hstepB, voffB); PG8_STAGE(PG8_SA(0, 0), a2, voffA); PG8_SCHED; PG8_LDA(At, 0, 1);
            PG8_WAIT_V(8); PG8_WAIT_L(0); PG8_BAR; PG8_MMA(1, 0, At, B0); PG8_MMA(1, 1, At, B1); PG8_BAR; PG8_SCHED;
            PG8_STAGE(PG8_SA(0, 1), a2 + hstepA, voffA); PG8_SCHED; PG8_LDB(B0, 1, 0); PG8_LDB(B1, 1, 1); PG8_SCHED; PG8_LDA(At, 1, 0);
            PG8_WAIT_V(8); PG8_WAIT_L(0); PG8_BAR; PG8_MMA(0, 0, At, B0); PG8_MMA(0, 1, At, B1); PG8_BAR; PG8_SCHED;
            PG8_STAGE(PG8_SB(1, 0), b3, voffB); PG8_STAGE(PG8_SB(1, 1), b3 + hstepB, voffB); PG8_STAGE(PG8_SA(1, 0), a3, voffA); PG8_SCHED; PG8_LDA(At, 1, 1);
            PG8_WAIT_V(8); PG8_WAIT_L(0); PG8_BAR; PG8_MMA(1, 0, At, B0); PG8_MMA(1, 1, At, B1); PG8_BAR; PG8_SCHED;
        }
        if (wr == 0) PG8_BAR;
        E(acc, cur, wr, wc, fr, fq, rpre);
        if (!has_next) break;
#pragma unroll
        for (int a = 0; a < 2; ++a)
#pragma unroll
            for (int b = 0; b < 2; ++b)
#pragma unroll
                for (int m = 0; m < 4; ++m)
#pragma unroll
                    for (int n = 0; n < 2; ++n) acc[a][b][m][n] = (f32x4){0.f, 0.f, 0.f, 0.f};
        cur = nxt; cA = nA; cB = nB; ++ui;
        if (wr == 1) PG8_BAR;
    }
    PG8_WAIT_V(0);
    PG8_BAR;
#undef PG8_SA
#undef PG8_SB
#undef PG8_STAGE
#undef PG8_LDA
#undef PG8_LDB
#undef PG8_MMA
#undef PG8_WAIT_V
#undef PG8_WAIT_L
#undef PG8_BAR
#undef PG8_SCHED
}
}

constexpr size_t MiB = 1u << 20;
constexpr size_t WS_WIN = 0;
constexpr size_t WS_WOUT = 176 * MiB;
constexpr size_t WS_WLIN = 264 * MiB;
constexpr size_t WS_WG = 280 * MiB;
constexpr size_t WS_WLOUT = 282 * MiB;
constexpr size_t WS_WKV = 290 * MiB;
constexpr size_t WS_WQ = 306 * MiB, WS_WO = 314 * MiB;
constexpr size_t WS_HN = 322 * MiB;
constexpr size_t WS_ACT = 354 * MiB;
constexpr size_t WS_XB = 442 * MiB;
constexpr size_t WS_XC = 506 * MiB, WS_HY = 538 * MiB;
constexpr size_t WS_GP = 570 * MiB;
constexpr size_t WS_SP = 698 * MiB, WS_SH = 700 * MiB;
constexpr size_t WS_KV = 702 * MiB;
constexpr size_t WS_K = 766 * MiB, WS_VT = 798 * MiB;
constexpr size_t WS_KMEAN = 830 * MiB;
constexpr size_t WS_Q = 831 * MiB;
constexpr size_t WS_O = 895 * MiB;
constexpr size_t WS_C8 = 927 * MiB;
constexpr size_t WS_PP = 927 * MiB + 256 * 1024, WS_PH = 927 * MiB + 512 * 1024;
constexpr size_t WS_BAR = 928 * MiB;
constexpr size_t WS_SS = 929 * MiB;
constexpr size_t WS_END = 930 * MiB;

constexpr int LDS_BYTES = 147456;

struct Args { const float* in[17]; float* out; unsigned char* ws; };

__device__ __forceinline__ long map_src(int type, int n0) {
    if (type == 0) return n0;
    const int t = n0 >> 8, w = n0 & 255, bj = w >> 7, f = w & 127;
    if (type == 1) return (bj ? FF : 0) + 128 * t + f;
    return (long)((n0 >> 11) * 8 + ((n0 & 2047) >> 8)) * 65536 + (n0 & 255);
}
__device__ __forceinline__ void conv_load(const float* src, int ld, int lane, f32x4 (&v)[16]) {
    const float* sp = src + (size_t)(16 * (lane >> 4)) * ld + 4 * (lane & 15);
#pragma unroll
    for (int i = 0; i < 16; ++i) v[i] = __builtin_nontemporal_load((const f32x4*)(sp + (size_t)i * ld));
}
__device__ __forceinline__ void conv_store(f32x4 (&v)[16], int K, const float* gain, bf16* dst, LAS unsigned char* scr, int k0, int lane) {
    const int q = lane >> 4, c = lane & 15;
    if (gain) {
#pragma unroll
        for (int i4 = 0; i4 < 4; ++i4) { const f32x4 g = *(const f32x4*)(gain + k0 + 16 * q + 4 * i4);
#pragma unroll
            for (int i = 0; i < 4; ++i) v[4 * i4 + i] *= g[i]; }
    }
#pragma unroll
    for (int j = 0; j < 4; ++j)
#pragma unroll
        for (int hh = 0; hh < 2; ++hh) { u32x4 o; o.x = pk2(v[8 * hh][j], v[8 * hh + 1][j]); o.y = pk2(v[8 * hh + 2][j], v[8 * hh + 3][j]); o.z = pk2(v[8 * hh + 4][j], v[8 * hh + 5][j]); o.w = pk2(v[8 * hh + 6][j], v[8 * hh + 7][j]);
            *(LAS u32x4*)(scr + (4 * c + j) * 128 + (((2 * q + hh) ^ (c & 7)) << 4)) = o; }
    asm volatile("s_waitcnt lgkmcnt(0)" ::: "memory");
#pragma unroll
    for (int r = 0; r < 8; ++r) { const int L = lane + 64 * r, n = L >> 3, kc = L & 7;
        const u32x4 o = *(const LAS u32x4*)(scr + n * 128 + ((kc ^ ((n >> 2) & 7)) << 4));
        *(u32x4*)(dst + (size_t)n * K + k0 + 8 * kc) = o; }
    asm volatile("s_waitcnt lgkmcnt(0)" ::: "memory");
}

__device__ __forceinline__ void p_convert(const Args& A, LAS unsigned char* lds, int j0, int j1, int gw, int NGW, int wave, int lane) {
    asm volatile("" : "+v"(lane));
    LAS unsigned char* scr = lds + wave * 8192;
    unsigned char* ws = A.ws;
    for (int j = j0; j < j1; ++j) {
        const float* src; int ld, K, Nout, type = 0; const float* gain = nullptr; bf16* dst;
        if (j < 4) { src = A.in[2] + (size_t)j * D * 2 * FF; ld = 2 * FF; K = D; Nout = 2 * FF; type = 1; gain = A.in[1] + ((j >> 1) * 3 + (j & 1) * 2) * D; dst = (bf16*)(ws + WS_WIN) + (size_t)j * 2 * FF * D; }
        else if (j < 8) { const int q = j - 4; src = A.in[3] + (size_t)q * FF * D; ld = D; K = FF; Nout = D; dst = (bf16*)(ws + WS_WOUT) + (size_t)q * D * FF; }
        else if (j == 8) { src = A.in[4]; ld = 2 * D; K = D; Nout = 2 * D; gain = A.in[1] + 1 * D; dst = (bf16*)(ws + WS_WLIN); }
        else if (j == 9) { src = A.in[7]; ld = 256; K = 256; Nout = 4096; type = 2; dst = (bf16*)(ws + WS_WG); }
        else if (j == 10) { src = A.in[10]; ld = D; K = D; Nout = D; dst = (bf16*)(ws + WS_WLOUT); }
        else if (j == 11) { src = A.in[12]; ld = 2 * D; K = D; Nout = 2 * D; gain = A.in[11]; dst = (bf16*)(ws + WS_WKV); }
        else if (j == 12) { src = A.in[14]; ld = D; K = D; Nout = D; gain = A.in[1] + 4 * D; dst = (bf16*)(ws + WS_WQ); }
        else { src = A.in[16]; ld = D; K = D; Nout = D; dst = (bf16*)(ws + WS_WO); }
        const int nblk = Nout / 64, items = (K / 64) * nblk;
        int it = gw;
        f32x4 v[16];
        if (it < items) { const int kb = it / nblk, nb = it - kb * nblk; conv_load(src + map_src(type, nb * 64) + (size_t)(kb * 64) * ld, ld, lane, v); }
        while (it < items) {
            const int nx = it + NGW;
            f32x4 vn[16];
            if (nx < items) { const int kb = nx / nblk, nb = nx - kb * nblk; conv_load(src + map_src(type, nb * 64) + (size_t)(kb * 64) * ld, ld, lane, vn); }
            { const int kb = it / nblk, nb = it - kb * nblk; conv_store(v, K, gain, dst + (size_t)(nb * 64) * K, scr, kb * 64, lane); }
#pragma unroll
            for (int i = 0; i < 16; ++i) v[i] = vn[i];
            it = nx;
        }
    }
}

__device__ __forceinline__ void p_prep(const float* h, bf16* hb, pg8::u64* ss, int gw, int NGW, int lane) {
#pragma unroll 4
    for (int m = gw; m < M; m += NGW) {
        const f32x4* xr = (const f32x4*)(h + (size_t)m * D) + lane;
        u32x2* o = (u32x2*)(hb + (size_t)m * D) + lane;
        float t = 0.f;
#pragma unroll
        for (int j = 0; j < 8; ++j) { const f32x4 v = xr[64 * j]; t += (v.x * v.x + v.y * v.y) + (v.z * v.z + v.w * v.w); u32x2 w; w.x = pk2(v.x, v.y); w.y = pk2(v.z, v.w); o[64 * j] = w; }
        t = wave_sum(t);
        if (lane == 0) ss[m] = (pg8::u64)__float2ull_rn(t * pg8::SS_SCALE);
    }
}

__device__ __forceinline__ void conv_item(const bf16* xb, const float* cw, const float* cb, bf16* xc, int item) {
    {
        const int c0 = (item & 255) * 8, t0 = (item >> 8) * 16;
        float w[4][8], bb[8], x0[8], x1[8], x2[8];
#pragma unroll
        for (int i = 0; i < 8; ++i) { bb[i] = cb[c0 + i];
#pragma unroll
            for (int tp = 0; tp < 4; ++tp) w[tp][i] = cw[tp * D + c0 + i]; }
        auto ld8 = [&](int row, float* d) { const u32x4 q = *(const u32x4*)(xb + (size_t)row * 4096 + c0);
            d[0] = bflo(q.x); d[1] = bfhi(q.x); d[2] = bflo(q.y); d[3] = bfhi(q.y); d[4] = bflo(q.z); d[5] = bfhi(q.z); d[6] = bflo(q.w); d[7] = bfhi(q.w); };
        if ((t0 & (SEQ - 1)) == 0) {
#pragma unroll
            for (int i = 0; i < 8; ++i) { x0[i] = 0.f; x1[i] = 0.f; x2[i] = 0.f; }
        } else { ld8(t0 - 3, x0); ld8(t0 - 2, x1); ld8(t0 - 1, x2); }
#pragma unroll
        for (int t = 0; t < 16; ++t) { float x3[8], y[8]; ld8(t0 + t, x3);
#pragma unroll
            for (int i = 0; i < 8; ++i) { y[i] = bb[i] + w[0][i] * x0[i] + w[1][i] * x1[i] + w[2][i] * x2[i] + w[3][i] * x3[i]; x0[i] = x1[i]; x1[i] = x2[i]; x2[i] = x3[i]; }
            u32x4 o; o.x = pk2(y[0], y[1]); o.y = pk2(y[2], y[3]); o.z = pk2(y[4], y[5]); o.w = pk2(y[6], y[7]);
            *(u32x4*)(xc + (size_t)(t0 + t) * D + c0) = o; }
    }
}

__device__ __forceinline__ void p_conv(const bf16* xb, const float* cw, const float* cb, bf16* xc, int gtid, int nthr) {
    for (int item = gtid; item < 256 * 512; item += nthr) conv_item(xb, cw, cb, xc, item);
}
__device__ __forceinline__ void lru_au(const bf16* gp, const bf16* xc, size_t r, int c4, const f32x4 br, const f32x4 bi, const f32x4 c8, f32x4& av, f32x4& uv) {
    const u32x2 rw = *(const u32x2*)(gp + r * 4096 + c4), iw = *(const u32x2*)(gp + r * 4096 + D + c4), xw = *(const u32x2*)(xc + r * D + c4);
    const float rp[4] = {bflo(rw.x), bfhi(rw.x), bflo(rw.y), bfhi(rw.y)}, ip[4] = {bflo(iw.x), bfhi(iw.x), bflo(iw.y), bfhi(iw.y)}, xv[4] = {bflo(xw.x), bfhi(xw.x), bflo(xw.y), bfhi(xw.y)};
#pragma unroll
    for (int j = 0; j < 4; ++j) { const float rg = sigmoidf_(rp[j] + br[j]), ig = sigmoidf_(ip[j] + bi[j]);
        const float aa = __builtin_amdgcn_exp2f(c8[j] * rg); av[j] = aa; uv[j] = xv[j] * ig * __builtin_amdgcn_sqrtf((1.0f - aa) * (1.0f + aa)); }
}
__device__ __forceinline__ void scan_a_item(const bf16* gp, const bf16* xc, const float* gb, const float* c8t, float* SP, float* SH, int item, f32x4& pout, f32x4& hout) {
    {
        const int c4 = (item & 511) * 4, k = (item >> 9) & 127, b = item >> 16;
        const f32x4 br = *(const f32x4*)(gb + c4), bi = *(const f32x4*)(gb + D + c4), c8 = *(const f32x4*)(c8t + c4);
        const size_t row0 = (size_t)(b * SEQ + k * 32);
        f32x4 p = {1.f, 1.f, 1.f, 1.f}, h = {0.f, 0.f, 0.f, 0.f};
#pragma unroll 8
        for (int t = 0; t < 32; ++t) { f32x4 av, uv; lru_au(gp, xc, row0 + t, c4, br, bi, c8, av, uv); h = av * h + uv; p = p * av; }
        const size_t o = (size_t)(b * 128 + k) * D + c4;
        *(f32x4*)(SP + o) = p; *(f32x4*)(SH + o) = h; pout = p; hout = h;
    }
}
__device__ __forceinline__ void p_scan_a(const bf16* gp, const bf16* xc, const float* gb, const float* c8t, float* SP, float* SH, int gtid, int nthr) {
    for (int item = gtid; item < 2 * 128 * 512; item += nthr) { f32x4 p_, h_; scan_a_item(gp, xc, gb, c8t, SP, SH, item, p_, h_); }
}
__device__ __forceinline__ void p_scan_b(const bf16* gp, const bf16* xc, const float* gb, const float* c8t, const float* SP, const float* SH, const float* PP, const float* PH, const bf16* yg  , bf16* hy, int gtid, int nthr) {
    for (int item = gtid; item < 2 * 128 * 512; item += nthr) {
        const int c4 = (item & 511) * 4, k = (item >> 9) & 127, b = item >> 16;
        const f32x4 br = *(const f32x4*)(gb + c4), bi = *(const f32x4*)(gb + D + c4), c8 = *(const f32x4*)(c8t + c4);
        f32x4 h = {0.f, 0.f, 0.f, 0.f};
        {
            const int pn_ = k >> 3, jn_ = k & 7;
            f32x4 pp[16], hh[16];
#pragma unroll
            for (int i = 0; i < 15; ++i) if (i < pn_) { const size_t o = (size_t)(b * 16 + i) * D + c4; pp[i] = *(const f32x4*)(PP + o); hh[i] = *(const f32x4*)(PH + o); }
#pragma unroll
            for (int i = 0; i < 15; ++i) if (i < pn_) h = pp[i] * h + hh[i];
#pragma unroll
            for (int i = 0; i < 7; ++i) if (i < jn_) { const size_t o = (size_t)(b * 128 + pn_ * 8 + i) * D + c4; pp[i] = *(const f32x4*)(SP + o); hh[i] = *(const f32x4*)(SH + o); }
#pragma unroll
            for (int i = 0; i < 7; ++i) if (i < jn_) h = pp[i] * h + hh[i];
        }
        const size_t row0 = (size_t)(b * SEQ + k * 32);
#pragma unroll 8
        for (int t = 0; t < 32; ++t) { const size_t r = row0 + t; f32x4 av, uv; lru_au(gp, xc, r, c4, br, bi, c8, av, uv); h = av * h + uv;
            const u32x2 y = *(const u32x2*)(yg + r * 4096 + D + c4); u32x2 o; o.x = pk2(h.x * bflo(y.x), h.y * bfhi(y.x)); o.y = pk2(h.z * bflo(y.y), h.w * bfhi(y.y));
            *(u32x2*)(hy + r * D + c4) = o; }
    }
}

__device__ __forceinline__ void p_knorm(const bf16* kv, const float* kg, bf16* Kn, bf16* Vt, float* kmean, LAS unsigned char* lds, int tid) {
    asm volatile("" : "+v"(tid));
    const int w = tid >> 6, lane = tid & 63;
    LAS float* red = (LAS float*)lds;
    LAS unsigned short* vl = (LAS unsigned short*)(lds + 4096);
    for (int item = blockIdx.x; item < 512; item += gridDim.x) {
        const int bh = item >> 4, n = item & 15, b = bh >> 4, h = bh & 15;
        const size_t tok0 = (size_t)b * SEQ + n * 256;
        {
            const int sub = lane >> 4, l16 = lane & 15;
            const f32x4 ga = *(const f32x4*)(kg + 8 * l16), gb = *(const f32x4*)(kg + 8 * l16 + 4);
            const float g[8] = {ga.x, ga.y, ga.z, ga.w, gb.x, gb.y, gb.z, gb.w};
            float cs[8] = {0.f, 0.f, 0.f, 0.f, 0.f, 0.f, 0.f, 0.f};
#pragma unroll
            for (int it = 0; it < 8; ++it) { const int key = 32 * w + 4 * it + sub;
                const u32x4 raw = *(const u32x4*)(kv + (tok0 + key) * 4096 + h * HD + 8 * l16);
                const float x[8] = {bflo(raw.x), bfhi(raw.x), bflo(raw.y), bfhi(raw.y), bflo(raw.z), bfhi(raw.z), bflo(raw.w), bfhi(raw.w)};
                float q = 0.f;
#pragma unroll
                for (int i = 0; i < 8; ++i) q += x[i] * x[i];
                q += __shfl_xor(q, 1); q += __shfl_xor(q, 2); q += __shfl_xor(q, 4); q += __shfl_xor(q, 8);
                const float rinv = rsqrtf(q * (1.0f / HD) + EPS);
                float y[8];
#pragma unroll
                for (int i = 0; i < 8; ++i) { y[i] = x[i] * rinv * g[i]; cs[i] += y[i]; }
                u32x4 o; o.x = pk2(y[0], y[1]); o.y = pk2(y[2], y[3]); o.z = pk2(y[4], y[5]); o.w = pk2(y[6], y[7]);
                *(u32x4*)(Kn + ((size_t)bh * SEQ + n * 256 + key) * HD + 8 * l16) = o; }
#pragma unroll
            for (int i = 0; i < 8; ++i) { cs[i] += __shfl_xor(cs[i], 16); cs[i] += __shfl_xor(cs[i], 32); if (sub == 0) red[w * 128 + 8 * l16 + i] = cs[i]; }
        }
        for (int idx = tid; idx < 256 * 16; idx += 512) { const int key = idx >> 4, ch = idx & 15;
            const u32x4 q = *(const u32x4*)(kv + (tok0 + key) * 4096 + D + h * HD + ch * 8);
            LAS unsigned* d = (LAS unsigned*)(vl + key * 130 + ch * 8); d[0] = q.x; d[1] = q.y; d[2] = q.z; d[3] = q.w; }
        __syncthreads();
        if (tid < 128) { float s = 0.f;
#pragma unroll
            for (int ww = 0; ww < 8; ++ww) s += red[ww * 128 + tid];
            kmean[((size_t)bh * 16 + n) * HD + tid] = s * (1.0f / 256.0f); }
        for (int idx = tid; idx < 128 * 32; idx += 512) { const int d = idx >> 5, ck = idx & 31, g = ck >> 1, kgp = ck & 1;
            unsigned short e[8];
#pragma unroll
            for (int i = 0; i < 8; ++i) { const int key = 16 * g + (i < 4 ? 4 * kgp + i : 8 + 4 * kgp + (i - 4)); e[i] = vl[key * 130 + d]; }
            u32x4 o; o.x = e[0] | ((unsigned)e[1] << 16); o.y = e[2] | ((unsigned)e[3] << 16); o.z = e[4] | ((unsigned)e[5] << 16); o.w = e[6] | ((unsigned)e[7] << 16);
            *(u32x4*)(Vt + ((size_t)bh * HD + d) * SEQ + n * 256 + ck * 8) = o; }
        __syncthreads();
    }
}

constexpr int AT_KROW = 272, AT_VROW = 144, AT_KBUF = 64 * AT_KROW, AT_VBUF = 128 * AT_VROW, AT_K0 = 0, AT_V0 = 2 * AT_KBUF, AT_KM = AT_V0 + 2 * AT_VBUF;
#define MFMA32(a, b, c) __builtin_amdgcn_mfma_f32_32x32x16_bf16((a), (b), (c), 0, 0, 0)
__device__ __forceinline__ bf16x8 pack8(float a0, float a1, float a2, float a3, float a4, float a5, float a6, float a7) {
    u32x4 p; p.x = pk2(a0, a1); p.y = pk2(a2, a3); p.z = pk2(a4, a5); p.w = pk2(a6, a7); return __builtin_bit_cast(bf16x8, p); }

__device__ __forceinline__ void attn_unit(int bh, int ob, const bf16* qraw, const float* qg, const bf16* Kn, const bf16* Vt, const float* kmean, bf16* O, LAS unsigned char* lds, int tid) {
    asm volatile("" : "+v"(tid));
    const int w = tid >> 6, lane = tid & 63, ql = lane & 31, hi = lane >> 5, b = bh >> 4, h = bh & 15;
    __syncthreads();
    ((LAS f32x4*)(lds + AT_KM))[tid] = ((const f32x4*)(kmean + (size_t)bh * 2048))[tid];
    __syncthreads();
    const int qi = 32 * w + ql;
    const int ntiles = 4 * (ob + 1);
    const bf16* Kbase = Kn + (size_t)bh * SEQ * HD;
    const bf16* Vbase = Vt + (size_t)bh * HD * SEQ;
    u32x4 pk0, pk1, pv0, pv1;
    auto prefetch = [&](int it) { const int s0 = (it >> 2) * 256 + (it & 3) * 64;
        const char* kp = (const char*)(Kbase + (size_t)s0 * HD); pk0 = *(const u32x4*)(kp + tid * 16); pk1 = *(const u32x4*)(kp + 8192 + tid * 16);
        const int d = tid >> 3, c = tid & 7; pv0 = *(const u32x4*)(Vbase + (size_t)d * SEQ + s0 + c * 8); pv1 = *(const u32x4*)(Vbase + (size_t)(d + 64) * SEQ + s0 + c * 8); };
    prefetch(0);
    const size_t tok = (size_t)b * SEQ + ob * 256 + qi;
    bf16x8 qb[8]; unsigned sel = 0;
    {
        const bf16* qp = qraw + tok * D + h * HD + 8 * hi;
        float qf[64]; float ss = 0.f;
#pragma unroll
        for (int s = 0; s < 8; ++s) {
            const u32x4 xw = *(const u32x4*)(qp + 16 * s);
            const float x[8] = {bflo(xw.x), bfhi(xw.x), bflo(xw.y), bfhi(xw.y), bflo(xw.z), bfhi(xw.z), bflo(xw.w), bfhi(xw.w)};
            const f32x4 g0 = *(const f32x4*)(qg + 16 * s + 8 * hi), g1 = *(const f32x4*)(qg + 16 * s + 8 * hi + 4);
#pragma unroll
            for (int i = 0; i < 4; ++i) { ss += x[i] * x[i] + x[4 + i] * x[4 + i]; qf[8 * s + i] = x[i] * g0[i]; qf[8 * s + 4 + i] = x[4 + i] * g1[i]; }
        }
        ss += __shfl_xor(ss, 32);
        const float rs = rsqrtf(ss * (1.0f / HD) + EPS) * (0.08838834764831845f * 1.4426950408889634f);
        if (ob > 0) {
            float gate[15];
            const LAS float* km = (const LAS float*)(lds + AT_KM) + 8 * hi;
#pragma unroll
            for (int n = 0; n < 15; ++n) {
                float acc = 0.f;
                if (n < ob) {
#pragma unroll
                    for (int s = 0; s < 8; ++s) { const f32x4 k0 = *(const LAS f32x4*)(km + n * 128 + 16 * s), k1 = *(const LAS f32x4*)(km + n * 128 + 16 * s + 4);
#pragma unroll
                        for (int i = 0; i < 4; ++i) { acc += qf[8 * s + i] * k0[i]; acc += qf[8 * s + 4 + i] * k1[i]; } }
                    acc += __shfl_xor(acc, 32);
                }
                gate[n] = acc;
            }
#pragma unroll
            for (int pick = 0; pick < 3; ++pick) if (pick < ob) {
                float best = -INFINITY; int bi = 0;
#pragma unroll
                for (int n = 0; n < 15; ++n) { const bool c = (n < ob) && !((sel >> n) & 1u) && (gate[n] > best); best = c ? gate[n] : best; bi = c ? n : bi; }
                sel |= 1u << bi;
            }
        }
#pragma unroll
        for (int s = 0; s < 8; ++s) qb[s] = pack8(qf[8 * s] * rs, qf[8 * s + 1] * rs, qf[8 * s + 2] * rs, qf[8 * s + 3] * rs, qf[8 * s + 4] * rs, qf[8 * s + 5] * rs, qf[8 * s + 6] * rs, qf[8 * s + 7] * rs);
    }
    f32x16 ot[4];
#pragma unroll
    for (int dt = 0; dt < 4; ++dt)
#pragma unroll
        for (int r = 0; r < 16; ++r) ot[dt][r] = 0.f;
    float mrun = -1e30f, lrun = 0.f;
    for (int it = 0; it < ntiles; ++it) {
        const int buf = it & 1;
        { LAS unsigned char* kb = lds + AT_K0 + buf * AT_KBUF; const int o0 = tid * 16, o1 = 8192 + tid * 16;
          *(LAS u32x4*)(kb + (o0 >> 8) * AT_KROW + (o0 & 255)) = pk0; *(LAS u32x4*)(kb + (o1 >> 8) * AT_KROW + (o1 & 255)) = pk1;
          LAS unsigned char* vb = lds + AT_V0 + buf * AT_VBUF; const int d = tid >> 3, c = tid & 7;
          *(LAS u32x4*)(vb + d * AT_VROW + c * 16) = pv0; *(LAS u32x4*)(vb + (d + 64) * AT_VROW + c * 16) = pv1; }
        __syncthreads();
        if (it + 1 < ntiles) prefetch(it + 1);
        const int nb = it >> 2, kt = it & 3;
        const bool own = (nb == ob);
        const bool lane_ok = own || ((sel >> nb) & 1u);
        const bool active = own ? (64 * kt <= 32 * w + 31) : (__ballot(lane_ok) != 0ull);
        if (active) {
            f32x16 st0, st1;
#pragma unroll
            for (int r = 0; r < 16; ++r) { st0[r] = 0.f; st1[r] = 0.f; }
            const LAS unsigned char* kb = lds + AT_K0 + buf * AT_KBUF + ql * AT_KROW + hi * 16;
#pragma unroll
            for (int s = 0; s < 8; ++s) { const bf16x8 k0 = *(const LAS bf16x8*)(kb + s * 32), k1 = *(const LAS bf16x8*)(kb + 32 * AT_KROW + s * 32);
                st0 = MFMA32(k0, qb[s], st0); st1 = MFMA32(k1, qb[s], st1); }
            if (own) {
                if (64 * kt + 63 > 32 * w) {
#pragma unroll
                    for (int r = 0; r < 16; ++r) { const int kk = 64 * kt + (r & 3) + 8 * (r >> 2) + 4 * hi;
                        st0[r] = (kk <= qi) ? st0[r] : -INFINITY; st1[r] = (kk + 32 <= qi) ? st1[r] : -INFINITY; }
                }
            }
            float mx = fmaxf(st0[0], st1[0]);
#pragma unroll
            for (int r = 1; r < 16; ++r) mx = fmaxf(mx, fmaxf(st0[r], st1[r]));
            mx = lane_ok ? mx : -INFINITY;
            mx = fmaxf(mx, __shfl_xor(mx, 32));
            const float mn = fmaxf(mrun, mx), alpha = __builtin_amdgcn_exp2f(mrun - mn);
            mrun = mn;
            const float msub = lane_ok ? mn : INFINITY;
            float ls = 0.f;
#pragma unroll
            for (int r = 0; r < 16; ++r) { st0[r] = __builtin_amdgcn_exp2f(st0[r] - msub); st1[r] = __builtin_amdgcn_exp2f(st1[r] - msub); ls += st0[r] + st1[r]; }
            lrun = lrun * alpha + ls;
            if (__ballot(alpha != 1.0f) != 0ull) {
#pragma unroll
                for (int dt = 0; dt < 4; ++dt)
#pragma unroll
                    for (int r = 0; r < 16; ++r) ot[dt][r] *= alpha;
            }
            const LAS unsigned char* vb = lds + AT_V0 + buf * AT_VBUF + ql * AT_VROW + hi * 16;
#pragma unroll
            for (int ks = 0; ks < 4; ++ks) {
                const int o = 8 * (ks & 1);
                const bf16x8 pf = (ks < 2) ? pack8(st0[o], st0[o + 1], st0[o + 2], st0[o + 3], st0[o + 4], st0[o + 5], st0[o + 6], st0[o + 7])
                                           : pack8(st1[o], st1[o + 1], st1[o + 2], st1[o + 3], st1[o + 4], st1[o + 5], st1[o + 6], st1[o + 7]);
#pragma unroll
                for (int dt = 0; dt < 4; ++dt) { const bf16x8 vf = *(const LAS bf16x8*)(vb + dt * 32 * AT_VROW + ks * 32); ot[dt] = MFMA32(vf, pf, ot[dt]); }
            }
        }
    }
    lrun += __shfl_xor(lrun, 32);
    const float inv = 1.0f / lrun;
    bf16* op = O + tok * D + h * HD + 4 * hi;
#pragma unroll
    for (int dt = 0; dt < 4; ++dt)
#pragma unroll
        for (int g4 = 0; g4 < 4; ++g4) { u32x2 o; o.x = pk2(ot[dt][4 * g4] * inv, ot[dt][4 * g4 + 1] * inv); o.y = pk2(ot[dt][4 * g4 + 2] * inv, ot[dt][4 * g4 + 3] * inv);
            *(u32x2*)(op + 32 * dt + 8 * g4) = o; }
}


#define XB_TMO      128
#define XB_XCNT(j)  (256  + 64 * (j))
#define XB_XSUB(j)  (1280 + 64 * (j))
#define XB_XGEN(j)  (2304 + 64 * (j))
#define XB_TOP      3328
#define XB_TOPGEN   3392
#define XCD_BAR_WORDS 3456
#define XB_SPIN_CAP (1u << 18)
__device__ __forceinline__ unsigned xb_ld(unsigned* p)              { return __hip_atomic_load(p, __ATOMIC_RELAXED, __HIP_MEMORY_SCOPE_AGENT); }
__device__ __forceinline__ unsigned xb_add(unsigned* p, unsigned v) { return __hip_atomic_fetch_add(p, v, __ATOMIC_RELAXED, __HIP_MEMORY_SCOPE_AGENT); }
__device__ __forceinline__ unsigned xb_xcc_id() { return (unsigned)__builtin_amdgcn_s_getreg((3 << 11) | 20) & 0xFu; }
#define XB_SPIN(cond, bar) do { unsigned _sp = 0; while (cond) { __builtin_amdgcn_s_sleep(1); \
    if ((++_sp & 255u) == 0u) { if (xb_ld(&(bar)[XB_TMO])) break; if (_sp > XB_SPIN_CAP) { atomicAdd(&(bar)[XB_TMO], 1u); break; } } } } while (0)
struct XcdBarrier { unsigned* bar; unsigned x; volatile LAS unsigned* st; };
__device__ __forceinline__ XcdBarrier xcd_barrier_post(unsigned* bar, volatile LAS unsigned* st) {
    XcdBarrier b; b.bar = bar; b.x = xb_xcc_id(); b.st = st;
    if (threadIdx.x == 0) (void)xb_add(&bar[XB_XCNT(b.x)], 1u);
    return b;
}
__device__ __forceinline__ void xcd_barrier_complete(unsigned* bar, unsigned x, unsigned& nloc, unsigned& nx) {
    const unsigned G = gridDim.x * gridDim.y * gridDim.z;
    unsigned sum, cnt, mine, sp = 0u;
    for (;;) {
        sum = 0u; cnt = 0u; mine = 0u;
#pragma unroll
        for (unsigned j = 0; j < 16; ++j) { const unsigned c = xb_ld(&bar[XB_XCNT(j)]); sum += c; cnt += (c > 0u) ? 1u : 0u; mine = (j == x) ? c : mine; }
        if (sum == G) break;
        __builtin_amdgcn_s_sleep(1);
        if ((++sp & 255u) == 0u) { if (xb_ld(&bar[XB_TMO])) break; if (sp > XB_SPIN_CAP) { atomicAdd(&bar[XB_TMO], 1u); break; } }
    }
    nloc = mine > 0u ? mine : 1u; nx = cnt > 0u ? cnt : 1u;
}
__device__ __forceinline__ void xcd_barrier(const XcdBarrier& b) {
    asm volatile("s_waitcnt vmcnt(0)" ::: "memory");
    __syncthreads();
    if (threadIdx.x == 0) {
        unsigned* bar = b.bar;
        __builtin_amdgcn_s_waitcnt(0);
        unsigned nloc = b.st[0], nx = b.st[1];
        if (nloc == 0u) { xcd_barrier_complete(bar, b.x, nloc, nx); b.st[0] = nloc; b.st[1] = nx; }
        const unsigned old = xb_add(&bar[XB_XSUB(b.x)], 1u);
        const unsigned gen = old / nloc;
        if (old + 1u == (gen + 1u) * nloc) {
            __builtin_amdgcn_fence(__ATOMIC_RELEASE, "agent");
            asm volatile("s_waitcnt vmcnt(0)" ::: "memory");
            const unsigned og = xb_add(&bar[XB_TOP], 1u);
            const unsigned tg = og / nx;
            if (og + 1u == (tg + 1u) * nx) xb_add(&bar[XB_TOPGEN], 1u);
            else XB_SPIN(xb_ld(&bar[XB_TOPGEN]) == tg, bar);
            __builtin_amdgcn_fence(__ATOMIC_ACQUIRE, "agent");
            xb_add(&bar[XB_XGEN(b.x)], 1u);
            asm volatile("s_waitcnt vmcnt(0)" ::: "memory");
        } else {
            XB_SPIN(xb_ld(&bar[XB_XGEN(b.x)]) == gen, bar);
            __builtin_amdgcn_fence(__ATOMIC_ACQUIRE, "agent");
            asm volatile("s_waitcnt vmcnt(0)" ::: "memory");
        }
    }
    __syncthreads();
}

__device__ __forceinline__ int opaque_(int v) { asm volatile("" : "+v"(v)); return v; }
__global__ void __launch_bounds__(512, 2) mega(Args A) {
    extern __shared__ __attribute__((aligned(16))) unsigned char lds_raw[];
    LAS unsigned char* lds = (LAS unsigned char*)lds_raw;
    cg::grid_group grid = cg::this_grid();
    const int tid = threadIdx.x;
#define lane (opaque_(tid) & 63)
#define wave __builtin_amdgcn_readfirstlane(opaque_(tid) >> 6)
#define gw ((int)blockIdx.x * 8 + wave)
#define gtid ((int)blockIdx.x * 512 + opaque_(tid))
    const int G = gridDim.x, NGW = G * 8, nthr = G * 512;
    unsigned char* ws = A.ws;
    bf16* ACT = (bf16*)(ws + WS_ACT);
    bf16* HB = (bf16*)(ws + WS_HN); pg8::u64* SS = (pg8::u64*)(ws + WS_SS);
    volatile LAS unsigned* xst = (volatile LAS unsigned*)(lds + LDS_BYTES - 16);
    if (tid < 4) xst[tid] = 0u;
    __syncthreads();
    XcdBarrier xbar = xcd_barrier_post((unsigned*)(ws + WS_BAR), xst);
#define SEAM() xcd_barrier(xbar)
#define GEMM(EpiT, Aop, Bop, N_, K_, lda_, amask, astr, ...) do { pg8::Gemm g{Aop, Bop, M, N_, K_, lda_, amask, astr}; pg8::StaticOrder S; S.init(M, N_, G, (int)blockIdx.x); \
        EpiT E{__VA_ARGS__}; pg8::gemm_phase<EpiT>(lds, g, S, E); } while (0)
#define SSB(k) (SS + (size_t)(k) * M)
#define IDLE_CONVERT(j) do { const bool half_ = (G == 256); if (!half_ || blockIdx.x >= 128) { const int gw_ = half_ ? ((int)blockIdx.x - 128) * 8 + wave : gw, ngw_ = half_ ? 128 * 8 : NGW; \
        p_convert(A, lds, 4 + (j), 5 + (j), gw_, ngw_, wave, lane); if ((j) < 3) p_convert(A, lds, (j) + 1, (j) + 2, gw_, ngw_, wave, lane); \
        if ((j) == 1) p_convert(A, lds, 11, 12, gw_, ngw_, wave, lane); if ((j) == 2) p_convert(A, lds, 12, 14, gw_, ngw_, wave, lane); } } while (0)
#define FFN_IN(j, ssin) GEMM(pg8::EpiSwiGLU, HB, (const bf16*)(ws + WS_WIN) + (size_t)(j) * 2 * FF * D, 2 * FF, D, D, 0, 0, ACT, ssin)
#define FFN_OUT(j, ssout, outp) GEMM(pg8::EpiResid, ACT, (const bf16*)(ws + WS_WOUT) + (size_t)(j) * D * FF, D, FF, FF, 0, 0, HB, ssout, outp, 0.5f)
    p_convert(A, lds, 0, 1, gw, NGW, wave, lane);
    p_convert(A, lds, 8, 11, gw, NGW, wave, lane);
    p_prep(A.in[0], HB, SSB(0), gw, NGW, lane);
    for (int c = gtid; c < D; c += nthr) { const float l = A.in[9][c]; ((float*)(ws + WS_C8))[c] = -8.0f * 1.4426950408889634f * (fmaxf(-l, 0.f) + log1pf(__expf(-fabsf(l)))); }
    for (int i = gtid; i < 5 * M; i += nthr) SS[M + i] = 0ull;
    if (A.ws == nullptr) grid.sync();
    SEAM();
    FFN_IN(0, SSB(0)); IDLE_CONVERT(0); SEAM();
    FFN_OUT(0, SSB(1), (float*)nullptr); SEAM();
    GEMM(pg8::EpiBf16, HB, (const bf16*)(ws + WS_WLIN), 2 * D, D, D, 0, 0, (bf16*)(ws + WS_XB), 4096, 8, SSB(1)); SEAM();
    { const int blk = (int)blockIdx.x;
        int t_ = tid; asm volatile("" : "+v"(t_));
        const int pm = blk >> 3, hh = blk & 7;
        conv_item((const bf16*)(ws + WS_XB), A.in[5], A.in[6], (bf16*)(ws + WS_XC), ((16 * pm + (t_ >> 5)) << 8) | (32 * hh + (t_ & 31)));
        asm volatile("s_waitcnt vmcnt(0)" ::: "memory"); __syncthreads();
        { pg8::Gemm g{(const bf16*)(ws + WS_XC), (const bf16*)(ws + WS_WG), M, 2 * D, 256, D, 7, 256}; pg8::PairOrder S{pm, hh}; pg8::EpiBf16 E{(bf16*)(ws + WS_GP), 4096, 1 << 30, (const pg8::u64*)nullptr};
          pg8::gemm_phase<pg8::EpiBf16, pg8::PairOrder>(lds, g, S, E); }
        asm volatile("s_waitcnt vmcnt(0)" ::: "memory"); __syncthreads();
        asm volatile("" : "+v"(t_));
        f32x4 pa, ha;
        scan_a_item((const bf16*)(ws + WS_GP), (const bf16*)(ws + WS_XC), A.in[8], (const float*)(ws + WS_C8), (float*)(ws + WS_SP), (float*)(ws + WS_SH), ((pm >> 4) << 16) | (((pm & 15) * 8 + (t_ >> 6)) << 9) | (64 * hh + (t_ & 63)), pa, ha);
        {
            LAS f32x4* agg = (LAS f32x4*)lds;
            agg[((t_ >> 6) * 64 + (t_ & 63)) * 2] = pa; agg[((t_ >> 6) * 64 + (t_ & 63)) * 2 + 1] = ha;
            __syncthreads();
            if ((t_ >> 6) == 0) { f32x4 P = {1.f, 1.f, 1.f, 1.f}, Hh = {0.f, 0.f, 0.f, 0.f};
#pragma unroll
                for (int j = 0; j < 8; ++j) { const f32x4 pj = agg[(j * 64 + t_) * 2], hj = agg[(j * 64 + t_) * 2 + 1]; Hh = pj * Hh + hj; P = P * pj; }
                const size_t o = (size_t)pm * D + 256 * hh + 4 * t_;
                *(f32x4*)((float*)(ws + WS_PP) + o) = P; *(f32x4*)((float*)(ws + WS_PH) + o) = Hh; }
        }
    }
    SEAM();
    p_scan_b((const bf16*)(ws + WS_GP), (const bf16*)(ws + WS_XC), A.in[8], (const float*)(ws + WS_C8), (const float*)(ws + WS_SP), (const float*)(ws + WS_SH), (const float*)(ws + WS_PP), (const float*)(ws + WS_PH), (const bf16*)(ws + WS_XB), (bf16*)(ws + WS_HY), gtid, nthr); SEAM();
    GEMM(pg8::EpiResid, (const bf16*)(ws + WS_HY), (const bf16*)(ws + WS_WLOUT), D, D, D, 0, 0, HB, SSB(2), (float*)nullptr, 1.0f); SEAM();
    FFN_IN(1, SSB(2)); IDLE_CONVERT(1); SEAM();
    FFN_OUT(1, SSB(3), (float*)nullptr); SEAM();
    GEMM(pg8::EpiBf16, HB, (const bf16*)(ws + WS_WKV), 2 * D, D, D, 0, 0, (bf16*)(ws + WS_KV), 4096, 1 << 30, SSB(3));
    FFN_IN(2, SSB(3)); IDLE_CONVERT(2); SEAM();
    p_knorm((const bf16*)(ws + WS_KV), A.in[13], (bf16*)(ws + WS_K), (bf16*)(ws + WS_VT), (float*)(ws + WS_KMEAN), lds, tid);
    FFN_OUT(2, SSB(4), (float*)nullptr); SEAM();
    GEMM(pg8::EpiBf16, HB, (const bf16*)(ws + WS_WQ), D, D, D, 0, 0, (bf16*)(ws + WS_Q), D, 1 << 30, SSB(4)); SEAM();
    for (int item = blockIdx.x; item < 256; item += G) { const int bh = item >> 3, sb = item & 7;
        attn_unit(bh, 15 - sb, (const bf16*)(ws + WS_Q), A.in[15], (const bf16*)(ws + WS_K), (const bf16*)(ws + WS_VT), (const float*)(ws + WS_KMEAN), (bf16*)(ws + WS_O), lds, tid);
        attn_unit(bh, sb, (const bf16*)(ws + WS_Q), A.in[15], (const bf16*)(ws + WS_K), (const bf16*)(ws + WS_VT), (const float*)(ws + WS_KMEAN), (bf16*)(ws + WS_O), lds, tid); }
    __syncthreads();
    SEAM();
    GEMM(pg8::EpiResid, (const bf16*)(ws + WS_O), (const bf16*)(ws + WS_WO), D, D, D, 0, 0, HB, SSB(5), (float*)nullptr, 1.0f); SEAM();
    FFN_IN(3, SSB(5)); IDLE_CONVERT(3); SEAM();
    FFN_OUT(3, (pg8::u64*)nullptr, A.out);
#undef SSB
#undef lane
#undef wave
#undef gw
#undef gtid
#undef IDLE_CONVERT
#undef SEAM
#undef GEMM
#undef FFN_IN
#undef FFN_OUT
}

extern "C" void kernel_launch(void* const* d_in, const int* in_sizes, int n_in, void* d_out, int out_size, void* d_ws, size_t ws_size, hipStream_t stream) {
    static int grid = 0;
    if (grid == 0) {
        if (n_in != 17 || out_size != M * D || ws_size < WS_END) { fprintf(stderr, "kernel_launch: unexpected shapes (n_in %d out %d ws %zu)\n", n_in, out_size, ws_size); grid = -1; return; }
        int dev = 0, cus = 0, per_cu = 0;
        hipGetDevice(&dev); hipDeviceGetAttribute(&cus, hipDeviceAttributeMultiprocessorCount, dev);
        if (hipFuncSetAttribute((const void*)mega, hipFuncAttributeMaxDynamicSharedMemorySize, LDS_BYTES) != hipSuccess) { fprintf(stderr, "kernel_launch: hipFuncSetAttribute failed\n"); grid = -1; return; }
        if (hipOccupancyMaxActiveBlocksPerMultiprocessor(&per_cu, (const void*)mega, 512, LDS_BYTES) != hipSuccess || per_cu < 1) { fprintf(stderr, "kernel_launch: occupancy query says %d\n", per_cu); per_cu = 1; }
        (void)hipGetLastError();
        grid = 256;
        if (cus * per_cu < 256) { fprintf(stderr, "kernel_launch: needs 256 co-resident workgroups, device offers %d\n", cus * per_cu); grid = -1; return; }
    }
    if (grid < 0) return;
    if (hipMemsetAsync((char*)d_ws + WS_BAR, 0, 16384, stream) != hipSuccess) { fprintf(stderr, "kernel_launch: memset failed\n"); return; }
    Args a{};
    for (int i = 0; i < 17; ++i) a.in[i] = (const float*)d_in[i];
    a.out = (float*)d_out; a.ws = (unsigned char*)d_ws;
    void* args[] = {&a};
    hipError_t e = hipLaunchCooperativeKernel((const void*)mega, dim3(grid), dim3(512), args, LDS_BYTES, stream);
    if (e != hipSuccess) fprintf(stderr, "cooperative launch failed: %s (grid %d)\n", hipGetErrorString(e), grid);
}
```

```cpp
#include <hip/hip_runtime.h>
#include <hip/hip_cooperative_groups.h>
#include <cstdio>
#include <cstdint>
namespace cg = cooperative_groups;

#define LAS __attribute__((address_space(3)))
typedef unsigned short bf16;
typedef short bf16x8 __attribute__((ext_vector_type(8)));
typedef float f32x4 __attribute__((ext_vector_type(4)));
typedef float f32x16 __attribute__((ext_vector_type(16)));
typedef unsigned u32x4 __attribute__((ext_vector_type(4)));
typedef unsigned u32x2 __attribute__((ext_vector_type(2)));
typedef __bf16 bf16x2_t __attribute__((ext_vector_type(2)));
typedef float f32x2_t __attribute__((ext_vector_type(2)));

__device__ __forceinline__ unsigned pk2(float lo, float hi) { f32x2_t v = {lo, hi}; bf16x2_t b = __builtin_convertvector(v, bf16x2_t); return __builtin_bit_cast(unsigned, b); }
__device__ __forceinline__ float bflo(unsigned w) { return __uint_as_float(w << 16); }
__device__ __forceinline__ float bfhi(unsigned w) { return __uint_as_float(w & 0xffff0000u); }
__device__ __forceinline__ float wave_sum(float v) {
#pragma unroll
    for (int o = 1; o < 64; o <<= 1) v += __shfl_xor(v, o);
    return v;
}
__device__ __forceinline__ float sigmoidf_(float x) { return __builtin_amdgcn_rcpf(1.0f + __builtin_amdgcn_exp2f(-1.4426950408889634f * x)); }

constexpr int M = 8192, D = 2048, FF = 5632, SEQ = 4096, NH = 16, HD = 128;
constexpr float EPS = 1e-6f;

namespace pg8 {
constexpr int BM = 256, BK = 64, HALF = 128, HTB = HALF * BK * 2, STAGE_BYTES = 8 * HTB, NXCD = 8, WGM = 8;
__host__ __device__ __forceinline__ int lds_byte(int r, int c) { const int st = (r >> 4) * 2 + (c >> 5), rr = r & 15, cc = c & 31, ob = rr * 64 + cc * 2; return st * 1024 + (ob ^ (((ob >> 9) & 1) << 5)); }
__host__ __device__ __forceinline__ void stage_rc(int b, int& R, int& C) { const int st = b / 1024, sb = b % 1024, swz = sb ^ (((sb >> 9) & 1) << 5); R = (st >> 1) * 16 + swz / 64; C = (st & 1) * 32 + (swz % 64) / 2; }
__host__ __device__ __forceinline__ int perm32(int rho) { const int n = rho >> 4, i = rho & 15; return 8 * (i >> 2) + 4 * n + (i & 3); }

struct Unit { int pm, pn; };
struct Gemm { const bf16* A; const bf16* Bt; int M, N, K, lda, a_mask, a_stride; };

struct StaticOrder {
    int nM, nN, nwg, G, c;
    __device__ void init(int M_, int N_, int G_, int c_) { nM = M_ / BM; nN = N_ / BM; nwg = nM * nN; G = G_; c = c_; }
    __device__ bool next(int i, Unit& u) const {
        const long L = (long)i * G + c; if (L >= nwg) return false;
        int wgid = (int)L; { const int q = nwg / NXCD, r = nwg % NXCD, xcd = wgid % NXCD, off = wgid / NXCD; wgid = (xcd < r ? xcd * (q + 1) : r * (q + 1) + (xcd - r) * q) + off; }
        const int nig = WGM * nN, gid = wgid / nig, fm = gid * WGM, gsz = (nM - fm) < WGM ? (nM - fm) : WGM;
        u.pm = fm + ((wgid % nig) % gsz); u.pn = (wgid % nig) / gsz; return true;
    }
};


typedef unsigned long long u64;
constexpr float SS_SCALE = 16777216.0f;
__device__ __forceinline__ void ssum_prefetch(const u64* ssum, const Unit& u, int wr, int fr, float (&rp)[2][4]) {
#pragma unroll
    for (int ai = 0; ai < 2; ++ai)
#pragma unroll
        for (int m = 0; m < 4; ++m) rp[ai][m] = ssum ? (float)ssum[u.pm * BM + wr * 64 + fr + ai * HALF + m * 16] * (1.0f / SS_SCALE) : 0.f;
}
__device__ __forceinline__ float rinv_of(float ssum) { return rsqrtf(ssum * (1.0f / D) + EPS); }
struct EpiResid {
    static constexpr bool PERM = true;
    bf16* hb; u64* ss; float* outf; float scale;
    __device__ __forceinline__ void prefetch(const Unit&, int, int, float (&)[2][4]) const {}
    __device__ __forceinline__ void operator()(const f32x4 (&acc)[2][2][4][2], const Unit& u, int wr, int wc, int fr, int fq, const float (&rp)[2][4]) const {
        const int row0 = u.pm * BM + wr * 64 + fr, col0 = u.pn * BM + wc * 32 + 8 * fq;
#pragma unroll
        for (int ai = 0; ai < 2; ++ai)
#pragma unroll
            for (int m = 0; m < 4; ++m) { const int row = row0 + ai * HALF + m * 16; const size_t off = (size_t)row * D + col0; float sq = 0.f;
#pragma unroll
                for (int bj = 0; bj < 2; ++bj) { const u32x4 bw = *(const u32x4*)(hb + off + bj * HALF);
                    const f32x4 v0 = acc[ai][bj][m][0] * scale + (f32x4){bflo(bw.x), bfhi(bw.x), bflo(bw.y), bfhi(bw.y)};
                    const f32x4 v1 = acc[ai][bj][m][1] * scale + (f32x4){bflo(bw.z), bfhi(bw.z), bflo(bw.w), bfhi(bw.w)};
                    if (outf) { *(f32x4*)(outf + off + bj * HALF) = v0; *(f32x4*)(outf + off + bj * HALF + 4) = v1; }
                    else { u32x4 w; w.x = pk2(v0.x, v0.y); w.y = pk2(v0.z, v0.w); w.z = pk2(v1.x, v1.y); w.w = pk2(v1.z, v1.w); *(u32x4*)(hb + off + bj * HALF) = w;
                        sq += ((v0.x * v0.x + v0.y * v0.y) + (v0.z * v0.z + v0.w * v0.w)) + ((v1.x * v1.x + v1.y * v1.y) + (v1.z * v1.z + v1.w * v1.w)); } }
                if (!outf) { sq += __shfl_xor(sq, 16); sq += __shfl_xor(sq, 32); if (fq == 0) atomicAdd(ss + row, (u64)__float2ull_rn(sq * SS_SCALE)); } }
    }
};
struct EpiSwiGLU {
    static constexpr bool PERM = true;
    bf16* out; const u64* ss;
    __device__ __forceinline__ void prefetch(const Unit& u, int wr, int fr, float (&rp)[2][4]) const { ssum_prefetch(ss, u, wr, fr, rp); }
    __device__ __forceinline__ void operator()(const f32x4 (&acc)[2][2][4][2], const Unit& u, int wr, int wc, int fr, int fq, const float (&rp)[2][4]) const {
        const int row0 = u.pm * BM + wr * 64 + fr, col0 = u.pn * HALF + wc * 32 + 8 * fq;
#pragma unroll
        for (int ai = 0; ai < 2; ++ai)
#pragma unroll
            for (int m = 0; m < 4; ++m) { float o[8]; const float ri = rinv_of(rp[ai][m]);
#pragma unroll
                for (int n = 0; n < 2; ++n)
#pragma unroll
                    for (int j = 0; j < 4; ++j) { const float g = acc[ai][0][m][n][j] * ri, up = acc[ai][1][m][n][j] * ri; o[4 * n + j] = g * sigmoidf_(g) * up; }
                u32x4 w; w.x = pk2(o[0], o[1]); w.y = pk2(o[2], o[3]); w.z = pk2(o[4], o[5]); w.w = pk2(o[6], o[7]);
                *(u32x4*)(out + (size_t)(row0 + ai * HALF + m * 16) * FF + col0) = w; }
    }
};
struct EpiBf16 {
    static constexpr bool PERM = true;
    bf16* out; int ldc; int gelu_from; const u64* ss;
    __device__ __forceinline__ void prefetch(const Unit& u, int wr, int fr, float (&rp)[2][4]) const { ssum_prefetch(ss, u, wr, fr, rp); }
    __device__ __forceinline__ void operator()(const f32x4 (&acc)[2][2][4][2], const Unit& u, int wr, int wc, int fr, int fq, const float (&rp)[2][4]) const {
        const int row0 = u.pm * BM + wr * 64 + fr, col0 = u.pn * BM + wc * 32 + 8 * fq;
        const bool act = u.pn >= gelu_from;
#pragma unroll
        for (int ai = 0; ai < 2; ++ai)
#pragma unroll
            for (int m = 0; m < 4; ++m) { const float ri = ss ? rinv_of(rp[ai][m]) : 1.0f;
#pragma unroll
                for (int bj = 0; bj < 2; ++bj) { float o[8];
#pragma unroll
                    for (int n = 0; n < 2; ++n)
#pragma unroll
                        for (int j = 0; j < 4; ++j) { float v = acc[ai][bj][m][n][j] * ri;
                            if (act) { const float z = 0.7978845608f * (v + 0.044715f * v * v * v); v = v * sigmoidf_(2.0f * z); }
                            o[4 * n + j] = v; }
                    u32x4 w; w.x = pk2(o[0], o[1]); w.y = pk2(o[2], o[3]); w.z = pk2(o[4], o[5]); w.w = pk2(o[6], o[7]);
                    *(u32x4*)(out + (size_t)(row0 + ai * HALF + m * 16) * ldc + col0 + bj * HALF) = w; } }
    }
};

struct PairOrder { int pm, h; __device__ __forceinline__ bool next(int i, Unit& u) const { if (i >= 2) return false; int p = pm, n = h + 8 * i; asm volatile("" : "+s"(p), "+s"(n));
        u.pm = p; u.pn = n; return true; } };

template <class Epi, class Sched = StaticOrder>
__device__ __forceinline__ void gemm_phase(LAS unsigned char* lds, const Gemm g, const Sched& S, const Epi& E) {
    int tid = threadIdx.x; asm volatile("" : "+v"(tid));
    const int wid = __builtin_amdgcn_readfirstlane(tid >> 6), lane = tid & 63, wr = wid >> 2, wc = wid & 3, fr = lane & 15, fq = lane >> 4;
    const int K = g.K, nt = K / BK, lda = g.lda;
    unsigned voffA[2], voffB[2];
#pragma unroll
    for (int i = 0; i < 2; ++i) { int R, C; stage_rc(tid * 16 + i * 8192, R, C); const int Rb = Epi::PERM ? ((R & ~31) + perm32(R & 31)) : R;
        voffA[i] = (unsigned)(R * lda + C) * 2u; voffB[i] = (unsigned)(Rb * K + C) * 2u; }
    const size_t kstep = (size_t)(BK * 2);
    const size_t hstepA = (size_t)HALF * lda * 2, hstepB = (size_t)HALF * K * 2;
    const size_t tstepA = 2 * hstepA, tstepB = 2 * hstepB;
    const unsigned ldsw = (unsigned)wid * 1024u;
    const int aoff = lds_byte(wr * 64 + fr, fq * 8), boff = lds_byte(wc * 32 + fr, fq * 8);
#define PG8_SA(b, h) (((b) * 2 + (h)) * HTB)
#define PG8_SB(b, h) ((4 + (b) * 2 + (h)) * HTB)
#define PG8_STAGE(bufoff, gbase, voff) do { _Pragma("unroll") for (int _i = 0; _i < 2; ++_i) \
        __builtin_amdgcn_global_load_lds((const unsigned*)((const char*)(gbase) + (voff)[_i]), (LAS unsigned*)(lds + (bufoff) + ldsw + _i * 8192), 16, 0, 0); } while (0)
#define PG8_LDA(dst, b, h) do { _Pragma("unroll") for (int m = 0; m < 4; ++m) _Pragma("unroll") for (int k = 0; k < 2; ++k) dst[m][k] = *(const LAS bf16x8*)(lds + PG8_SA(b, h) + aoff + m * 2048 + k * 1024); } while (0)
#define PG8_LDB(dst, b, h) do { _Pragma("unroll") for (int n = 0; n < 2; ++n) _Pragma("unroll") for (int k = 0; k < 2; ++k) dst[n][k] = *(const LAS bf16x8*)(lds + PG8_SB(b, h) + boff + n * 2048 + k * 1024); } while (0)
#define PG8_MMA(ai, bj, At, Bt) do { _Pragma("unroll") for (int m = 0; m < 4; ++m) _Pragma("unroll") for (int n = 0; n < 2; ++n) _Pragma("unroll") for (int k = 0; k < 2; ++k) \
        acc[ai][bj][m][n] = __builtin_amdgcn_mfma_f32_16x16x32_bf16(Bt[n][k], At[m][k], acc[ai][bj][m][n], 0, 0, 0); } while (0)
#define PG8_WAIT_V(n) asm volatile("s_waitcnt vmcnt(" #n ")" ::: "memory")
#define PG8_WAIT_L(n) asm volatile("s_waitcnt lgkmcnt(" #n ")" ::: "memory")
#define PG8_BAR __builtin_amdgcn_s_barrier()
#define PG8_SCHED __builtin_amdgcn_sched_barrier(0)
    Unit cur, nxt; int ui = 0;
    if (!S.next(0, cur)) return;
    f32x4 acc[2][2][4][2];
#pragma unroll
    for (int a = 0; a < 2; ++a)
#pragma unroll
        for (int b = 0; b < 2; ++b)
#pragma unroll
            for (int m = 0; m < 4; ++m)
#pragma unroll
                for (int n = 0; n < 2; ++n) acc[a][b][m][n] = (f32x4){0.f, 0.f, 0.f, 0.f};
    bf16x8 At[4][2], B0[2][2], B1[2][2];
    float rpre[2][4];
    const char* cA = (const char*)g.A + (size_t)cur.pm * tstepA + (size_t)((cur.pn & g.a_mask) * g.a_stride) * 2; const char* cB = (const char*)g.Bt + (size_t)cur.pn * tstepB;
    PG8_STAGE(PG8_SB(0, 0), cB, voffB); PG8_STAGE(PG8_SB(0, 1), cB + hstepB, voffB); PG8_STAGE(PG8_SA(0, 0), cA, voffA); PG8_STAGE(PG8_SA(0, 1), cA + hstepA, voffA);
    if (wr == 1) PG8_BAR;
    PG8_WAIT_V(2); PG8_BAR;
    PG8_STAGE(PG8_SB(1, 0), cB + kstep, voffB); PG8_STAGE(PG8_SA(1, 0), cA + kstep, voffA); PG8_STAGE(PG8_SB(1, 1), cB + hstepB + kstep, voffB);
    PG8_WAIT_V(6); PG8_BAR;
    for (;;) {
        const bool has_next = S.next(ui + 1, nxt);
        const char* nA = has_next ? (const char*)g.A + (size_t)nxt.pm * tstepA + (size_t)((nxt.pn & g.a_mask) * g.a_stride) * 2 : cA; const char* nB = has_next ? (const char*)g.Bt + (size_t)nxt.pn * tstepB : cB;
        for (int t = 0; t < nt; t += 2) {
            const bool last = (t == nt - 2);
            const char* a1 = cA + (size_t)(t + 1) * kstep;
            const char* a2 = last ? nA : cA + (size_t)(t + 2) * kstep; const char* b2 = last ? nB : cB + (size_t)(t + 2) * kstep;
            const char* a3 = a2 + kstep; const char* b3 = b2 + kstep;
            if (last) E.prefetch(cur, wr, fr, rpre);
            PG8_LDB(B0, 0, 0); PG8_LDB(B1, 0, 1); PG8_SCHED; PG8_LDA(At, 0, 0); PG8_STAGE(PG8_SA(1, 1), a1 + hstepA, voffA);
            PG8_WAIT_V(8); PG8_WAIT_L(0); __builtin_amdgcn_s_setprio(1); PG8_BAR; PG8_MMA(0, 0, At, B0); PG8_MMA(0, 1, At, B1); __builtin_amdgcn_s_setprio(0); PG8_BAR; PG8_SCHED;
            PG8_LDA(At, 0, 1); PG8_STAGE(PG8_SB(0, 0), b2, voffB); PG8_STAGE(PG8_SB(0, 1), b2 + hstepB, voffB); PG8_STAGE(PG8_SA(0, 0), a2, voffA);
            PG8_WAIT_V(8); PG8_WAIT_L(0); __builtin_amdgcn_s_setprio(1); PG8_BAR; PG8_MMA(1, 0, At, B0); PG8_MMA(1, 1, At, B1); __builtin_amdgcn_s_setprio(0); PG8_BAR; PG8_SCHED;
            PG8_LDB(B0, 1, 0); PG8_LDB(B1, 1, 1); PG8_SCHED; PG8_LDA(At, 1, 0); PG8_STAGE(PG8_SA(0, 1), a2 + hstepA, voffA);
            PG8_WAIT_V(8); PG8_WAIT_L(0); __builtin_amdgcn_s_setprio(1); PG8_BAR; PG8_MMA(0, 0, At, B0); PG8_MMA(0, 1, At, B1); __builtin_amdgcn_s_setprio(0); PG8_BAR; PG8_SCHED;
            PG8_LDA(At, 1, 1); PG8_STAGE(PG8_SB(1, 0), b3, voffB); PG8_STAGE(PG8_SB(1, 1), b3 + hstepB, voffB); PG8_STAGE(PG8_SA(1, 0), a3, voffA);
            PG8_WAIT_V(8); PG8_WAIT_L(0); __builtin_amdgcn_s_setprio(1); PG8_BAR; PG8_MMA(1, 0, At, B0); PG8_MMA(1, 1, At, B1); __builtin_amdgcn_s_setprio(0); PG8_BAR; PG8_SCHED;
        }
        if (wr == 0) PG8_BAR;
        E(acc, cur, wr, wc, fr, fq, rpre);
        if (!has_next) break;
#pragma unroll
        for (int a = 0; a < 2; ++a)
#pragma unroll
            for (int b = 0; b < 2; ++b)
#pragma unroll
                for (int m = 0; m < 4; ++m)
#pragma unroll
                    for (int n = 0; n < 2; ++n) acc[a][b][m][n] = (f32x4){0.f, 0.f, 0.f, 0.f};
        cur = nxt; cA = nA; cB = nB; ++ui;
        if (wr == 1) PG8_BAR;
    }
    PG8_WAIT_V(0);
    PG8_BAR;
#undef PG8_SA
#undef PG8_SB
#undef PG8_STAGE
#undef PG8_LDA
#undef PG8_LDB
#undef PG8_MMA
#undef PG8_WAIT_V
#undef PG8_WAIT_L
#undef PG8_BAR
#undef PG8_SCHED
}
}

constexpr size_t MiB = 1u << 20;
constexpr size_t WS_WIN = 0;
constexpr size_t WS_WOUT = 176 * MiB;
constexpr size_t WS_WLIN = 264 * MiB;
constexpr size_t WS_WG = 280 * MiB;
constexpr size_t WS_WLOUT = 282 * MiB;
constexpr size_t WS_WKV = 290 * MiB;
constexpr size_t WS_WQ = 306 * MiB, WS_WO = 314 * MiB;
constexpr size_t WS_HN = 322 * MiB;
constexpr size_t WS_ACT = 354 * MiB;
constexpr size_t WS_XB = 442 * MiB;
constexpr size_t WS_XC = 506 * MiB, WS_HY = 538 * MiB;
constexpr size_t WS_GP = 570 * MiB;
constexpr size_t WS_SP = 698 * MiB, WS_SH = 700 * MiB;
constexpr size_t WS_KV = 702 * MiB;
constexpr size_t WS_K = 766 * MiB, WS_VT = 798 * MiB;
constexpr size_t WS_KMEAN = 830 * MiB;
constexpr size_t WS_Q = 831 * MiB;
constexpr size_t WS_O = 895 * MiB;
constexpr size_t WS_C8 = 927 * MiB;
constexpr size_t WS_PP = 927 * MiB + 256 * 1024, WS_PH = 927 * MiB + 512 * 1024;
constexpr size_t WS_BAR = 928 * MiB;
constexpr size_t WS_SS = 929 * MiB;
constexpr size_t WS_END = 930 * MiB;

constexpr int LDS_BYTES = 147456;

struct Args { const float* in[17]; float* out; unsigned char* ws; };

__device__ __forceinline__ long map_src(int type, int n0) {
    if (type == 0) return n0;
    const int t = n0 >> 8, w = n0 & 255, bj = w >> 7, f = w & 127;
    if (type == 1) return (bj ? FF : 0) + 128 * t + f;
    return (long)((n0 >> 11) * 8 + ((n0 & 2047) >> 8)) * 65536 + (n0 & 255);
}
__device__ __forceinline__ void conv_load(const float* src, int ld, int lane, f32x4 (&v)[16]) {
    const float* sp = src + (size_t)(16 * (lane >> 4)) * ld + 4 * (lane & 15);
#pragma unroll
    for (int i = 0; i < 16; ++i) v[i] = __builtin_nontemporal_load((const f32x4*)(sp + (size_t)i * ld));
}
__device__ __forceinline__ void conv_store(f32x4 (&v)[16], int K, const float* gain, bf16* dst, LAS unsigned char* scr, int k0, int lane) {
    const int q = lane >> 4, c = lane & 15;
    if (gain) {
#pragma unroll
        for (int i4 = 0; i4 < 4; ++i4) { const f32x4 g = *(const f32x4*)(gain + k0 + 16 * q + 4 * i4);
#pragma unroll
            for (int i = 0; i < 4; ++i) v[4 * i4 + i] *= g[i]; }
    }
#pragma unroll
    for (int j = 0; j < 4; ++j)
#pragma unroll
        for (int hh = 0; hh < 2; ++hh) { u32x4 o; o.x = pk2(v[8 * hh][j], v[8 * hh + 1][j]); o.y = pk2(v[8 * hh + 2][j], v[8 * hh + 3][j]); o.z = pk2(v[8 * hh + 4][j], v[8 * hh + 5][j]); o.w = pk2(v[8 * hh + 6][j], v[8 * hh + 7][j]);
            *(LAS u32x4*)(scr + (4 * c + j) * 128 + (((2 * q + hh) ^ (c & 7)) << 4)) = o; }
    asm volatile("s_waitcnt lgkmcnt(0)" ::: "memory");
#pragma unroll
    for (int r = 0; r < 8; ++r) { const int L = lane + 64 * r, n = L >> 3, kc = L & 7;
        const u32x4 o = *(const LAS u32x4*)(scr + n * 128 + ((kc ^ ((n >> 2) & 7)) << 4));
        *(u32x4*)(dst + (size_t)n * K + k0 + 8 * kc) = o; }
    asm volatile("s_waitcnt lgkmcnt(0)" ::: "memory");
}

__device__ __forceinline__ void p_convert(const Args& A, LAS unsigned char* lds, int j0, int j1, int gw, int NGW, int wave, int lane) {
    asm volatile("" : "+v"(lane));
    LAS unsigned char* scr = lds + wave * 8192;
    unsigned char* ws = A.ws;
    for (int j = j0; j < j1; ++j) {
        const float* src; int ld, K, Nout, type = 0; const float* gain = nullptr; bf16* dst;
        if (j < 4) { src = A.in[2] + (size_t)j * D * 2 * FF; ld = 2 * FF; K = D; Nout = 2 * FF; type = 1; gain = A.in[1] + ((j >> 1) * 3 + (j & 1) * 2) * D; dst = (bf16*)(ws + WS_WIN) + (size_t)j * 2 * FF * D; }
        else if (j < 8) { const int q = j - 4; src = A.in[3] + (size_t)q * FF * D; ld = D; K = FF; Nout = D; dst = (bf16*)(ws + WS_WOUT) + (size_t)q * D * FF; }
        else if (j == 8) { src = A.in[4]; ld = 2 * D; K = D; Nout = 2 * D; gain = A.in[1] + 1 * D; dst = (bf16*)(ws + WS_WLIN); }
        else if (j == 9) { src = A.in[7]; ld = 256; K = 256; Nout = 4096; type = 2; dst = (bf16*)(ws + WS_WG); }
        else if (j == 10) { src = A.in[10]; ld = D; K = D; Nout = D; dst = (bf16*)(ws + WS_WLOUT); }
        else if (j == 11) { src = A.in[12]; ld = 2 * D; K = D; Nout = 2 * D; gain = A.in[11]; dst = (bf16*)(ws + WS_WKV); }
        else if (j == 12) { src = A.in[14]; ld = D; K = D; Nout = D; gain = A.in[1] + 4 * D; dst = (bf16*)(ws + WS_WQ); }
        else { src = A.in[16]; ld = D; K = D; Nout = D; dst = (bf16*)(ws + WS_WO); }
        const int nblk = Nout / 64, items = (K / 64) * nblk;
        int it = gw;
        f32x4 v[16];
        if (it < items) { const int kb = it / nblk, nb = it - kb * nblk; conv_load(src + map_src(type, nb * 64) + (size_t)(kb * 64) * ld, ld, lane, v); }
        while (it < items) {
            const int nx = it + NGW;
            f32x4 vn[16];
            if (nx < items) { const int kb = nx / nblk, nb = nx - kb * nblk; conv_load(src + map_src(type, nb * 64) + (size_t)(kb * 64) * ld, ld, lane, vn); }
            { const int kb = it / nblk, nb = it - kb * nblk; conv_store(v, K, gain, dst + (size_t)(nb * 64) * K, scr, kb * 64, lane); }
#pragma unroll
            for (int i = 0; i < 16; ++i) v[i] = vn[i];
            it = nx;
        }
    }
}

__device__ __forceinline__ void p_prep(const float* h, bf16* hb, pg8::u64* ss, int gw, int NGW, int lane) {
#pragma unroll 4
    for (int m = gw; m < M; m += NGW) {
        const f32x4* xr = (const f32x4*)(h + (size_t)m * D) + lane;
        u32x2* o = (u32x2*)(hb + (size_t)m * D) + lane;
        float t = 0.f;
#pragma unroll
        for (int j = 0; j < 8; ++j) { const f32x4 v = xr[64 * j]; t += (v.x * v.x + v.y * v.y) + (v.z * v.z + v.w * v.w); u32x2 w; w.x = pk2(v.x, v.y); w.y = pk2(v.z, v.w); o[64 * j] = w; }
        t = wave_sum(t);
        if (lane == 0) ss[m] = (pg8::u64)__float2ull_rn(t * pg8::SS_SCALE);
    }
}

__device__ __forceinline__ void conv_item(const bf16* xb, const float* cw, const float* cb, bf16* xc, int item) {
    {
        const int c0 = (item & 255) * 8, t0 = (item >> 8) * 16;
        float w[4][8], bb[8], x0[8], x1[8], x2[8];
#pragma unroll
        for (int i = 0; i < 8; ++i) { bb[i] = cb[c0 + i];
#pragma unroll
            for (int tp = 0; tp < 4; ++tp) w[tp][i] = cw[tp * D + c0 + i]; }
        auto ld8 = [&](int row, float* d) { const u32x4 q = *(const u32x4*)(xb + (size_t)row * 4096 + c0);
            d[0] = bflo(q.x); d[1] = bfhi(q.x); d[2] = bflo(q.y); d[3] = bfhi(q.y); d[4] = bflo(q.z); d[5] = bfhi(q.z); d[6] = bflo(q.w); d[7] = bfhi(q.w); };
        if ((t0 & (SEQ - 1)) == 0) {
#pragma unroll
            for (int i = 0; i < 8; ++i) { x0[i] = 0.f; x1[i] = 0.f; x2[i] = 0.f; }
        } else { ld8(t0 - 3, x0); ld8(t0 - 2, x1); ld8(t0 - 1, x2); }
#pragma unroll
        for (int t = 0; t < 16; ++t) { float x3[8], y[8]; ld8(t0 + t, x3);
#pragma unroll
            for (int i = 0; i < 8; ++i) { y[i] = bb[i] + w[0][i] * x0[i] + w[1][i] * x1[i] + w[2][i] * x2[i] + w[3][i] * x3[i]; x0[i] = x1[i]; x1[i] = x2[i]; x2[i] = x3[i]; }
            u32x4 o; o.x = pk2(y[0], y[1]); o.y = pk2(y[2], y[3]); o.z = pk2(y[4], y[5]); o.w = pk2(y[6], y[7]);
            *(u32x4*)(xc + (size_t)(t0 + t) * D + c0) = o; }
    }
}

__device__ __forceinline__ void p_conv(const bf16* xb, const float* cw, const float* cb, bf16* xc, int gtid, int nthr) {
    for (int item = gtid; item < 256 * 512; item += nthr) conv_item(xb, cw, cb, xc, item);
}
__device__ __forceinline__ void lru_au(const bf16* gp, const bf16* xc, size_t r, int c4, const f32x4 br, const f32x4 bi, const f32x4 c8, f32x4& av, f32x4& uv) {
    const u32x2 rw = *(const u32x2*)(gp + r * 4096 + c4), iw = *(const u32x2*)(gp + r * 4096 + D + c4), xw = *(const u32x2*)(xc + r * D + c4);
    const float rp[4] = {bflo(rw.x), bfhi(rw.x), bflo(rw.y), bfhi(rw.y)}, ip[4] = {bflo(iw.x), bfhi(iw.x), bflo(iw.y), bfhi(iw.y)}, xv[4] = {bflo(xw.x), bfhi(xw.x), bflo(xw.y), bfhi(xw.y)};
#pragma unroll
    for (int j = 0; j < 4; ++j) { const float rg = sigmoidf_(rp[j] + br[j]), ig = sigmoidf_(ip[j] + bi[j]);
        const float aa = __builtin_amdgcn_exp2f(c8[j] * rg); av[j] = aa; uv[j] = xv[j] * ig * __builtin_amdgcn_sqrtf((1.0f - aa) * (1.0f + aa)); }
}
__device__ __forceinline__ void scan_a_item(const bf16* gp, const bf16* xc, const float* gb, const float* c8t, float* SP, float* SH, int item, f32x4& pout, f32x4& hout) {
    {
        const int c4 = (item & 511) * 4, k = (item >> 9) & 127, b = item >> 16;
        const f32x4 br = *(const f32x4*)(gb + c4), bi = *(const f32x4*)(gb + D + c4), c8 = *(const f32x4*)(c8t + c4);
        const size_t row0 = (size_t)(b * SEQ + k * 32);
        f32x4 p = {1.f, 1.f, 1.f, 1.f}, h = {0.f, 0.f, 0.f, 0.f};
#pragma unroll 8
        for (int t = 0; t < 32; ++t) { f32x4 av, uv; lru_au(gp, xc, row0 + t, c4, br, bi, c8, av, uv); h = av * h + uv; p = p * av; }
        const size_t o = (size_t)(b * 128 + k) * D + c4;
        *(f32x4*)(SP + o) = p; *(f32x4*)(SH + o) = h; pout = p; hout = h;
    }
}
__device__ __forceinline__ void p_scan_a(const bf16* gp, const bf16* xc, const float* gb, const float* c8t, float* SP, float* SH, int gtid, int nthr) {
    for (int item = gtid; item < 2 * 128 * 512; item += nthr) { f32x4 p_, h_; scan_a_item(gp, xc, gb, c8t, SP, SH, item, p_, h_); }
}
__device__ __forceinline__ void p_scan_b(const bf16* gp, const bf16* xc, const float* gb, const float* c8t, const float* SP, const float* SH, const float* PP, const float* PH, const bf16* yg  , bf16* hy, int gtid, int nthr) {
    for (int item = gtid; item < 2 * 128 * 512; item += nthr) {
        const int c4 = (item & 511) * 4, k = (item >> 9) & 127, b = item >> 16;
        const f32x4 br = *(const f32x4*)(gb + c4), bi = *(const f32x4*)(gb + D + c4), c8 = *(const f32x4*)(c8t + c4);
        f32x4 h = {0.f, 0.f, 0.f, 0.f};
        {
            const int pn_ = k >> 3, jn_ = k & 7;
            f32x4 pp[16], hh[16];
#pragma unroll
            for (int i = 0; i < 15; ++i) if (i < pn_) { const size_t o = (size_t)(b * 16 + i) * D + c4; pp[i] = *(const f32x4*)(PP + o); hh[i] = *(const f32x4*)(PH + o); }
#pragma unroll
            for (int i = 0; i < 15; ++i) if (i < pn_) h = pp[i] * h + hh[i];
#pragma unroll
            for (int i = 0; i < 7; ++i) if (i < jn_) { const size_t o = (size_t)(b * 128 + pn_ * 8 + i) * D + c4; pp[i] = *(const f32x4*)(SP + o); hh[i] = *(const f32x4*)(SH + o); }
#pragma unroll
            for (int i = 0; i < 7; ++i) if (i < jn_) h = pp[i] * h + hh[i];
        }
        const size_t row0 = (size_t)(b * SEQ + k * 32);
#pragma unroll 8
        for (int t = 0; t < 32; ++t) { const size_t r = row0 + t; f32x4 av, uv; lru_au(gp, xc, r, c4, br, bi, c8, av, uv); h = av * h + uv;
            const u32x2 y = *(const u32x2*)(yg + r * 4096 + D + c4); u32x2 o; o.x = pk2(h.x * bflo(y.x), h.y * bfhi(y.x)); o.y = pk2(h.z * bflo(y.y), h.w * bfhi(y.y));
            *(u32x2*)(hy + r * D + c4) = o; }
    }
}

__device__ __forceinline__ void p_knorm(const bf16* kv, const float* kg, bf16* Kn, bf16* Vt, float* kmean, LAS unsigned char* lds, int tid) {
    asm volatile("" : "+v"(tid));
    const int w = tid >> 6, lane = tid & 63;
    LAS float* red = (LAS float*)lds;
    LAS unsigned short* vl = (LAS unsigned short*)(lds + 4096);
    for (int item = blockIdx.x; item < 512; item += gridDim.x) {
        const int bh = item >> 4, n = item & 15, b = bh >> 4, h = bh & 15;
        const size_t tok0 = (size_t)b * SEQ + n * 256;
        {
            const int sub = lane >> 4, l16 = lane & 15;
            const f32x4 ga = *(const f32x4*)(kg + 8 * l16), gb = *(const f32x4*)(kg + 8 * l16 + 4);
            const float g[8] = {ga.x, ga.y, ga.z, ga.w, gb.x, gb.y, gb.z, gb.w};
            float cs[8] = {0.f, 0.f, 0.f, 0.f, 0.f, 0.f, 0.f, 0.f};
#pragma unroll
            for (int it = 0; it < 8; ++it) { const int key = 32 * w + 4 * it + sub;
                const u32x4 raw = *(const u32x4*)(kv + (tok0 + key) * 4096 + h * HD + 8 * l16);
                const float x[8] = {bflo(raw.x), bfhi(raw.x), bflo(raw.y), bfhi(raw.y), bflo(raw.z), bfhi(raw.z), bflo(raw.w), bfhi(raw.w)};
                float q = 0.f;
#pragma unroll
                for (int i = 0; i < 8; ++i) q += x[i] * x[i];
                q += __shfl_xor(q, 1); q += __shfl_xor(q, 2); q += __shfl_xor(q, 4); q += __shfl_xor(q, 8);
                const float rinv = rsqrtf(q * (1.0f / HD) + EPS);
                float y[8];
#pragma unroll
                for (int i = 0; i < 8; ++i) { y[i] = x[i] * rinv * g[i]; cs[i] += y[i]; }
                u32x4 o; o.x = pk2(y[0], y[1]); o.y = pk2(y[2], y[3]); o.z = pk2(y[4], y[5]); o.w = pk2(y[6], y[7]);
                *(u32x4*)(Kn + ((size_t)bh * SEQ + n * 256 + key) * HD + 8 * l16) = o; }
#pragma unroll
            for (int i = 0; i < 8; ++i) { cs[i] += __shfl_xor(cs[i], 16); cs[i] += __shfl_xor(cs[i], 32); if (sub == 0) red[w * 128 + 8 * l16 + i] = cs[i]; }
        }
        for (int idx = tid; idx < 256 * 16; idx += 512) { const int key = idx >> 4, ch = idx & 15;
            const u32x4 q = *(const u32x4*)(kv + (tok0 + key) * 4096 + D + h * HD + ch * 8);
            LAS unsigned* d = (LAS unsigned*)(vl + key * 130 + ch * 8); d[0] = q.x; d[1] = q.y; d[2] = q.z; d[3] = q.w; }
        __syncthreads();
        if (tid < 128) { float s = 0.f;
#pragma unroll
            for (int ww = 0; ww < 8; ++ww) s += red[ww * 128 + tid];
            kmean[((size_t)bh * 16 + n) * HD + tid] = s * (1.0f / 256.0f); }
        for (int idx = tid; idx < 128 * 32; idx += 512) { const int d = idx >> 5, ck = idx & 31, g = ck >> 1, kgp = ck & 1;
            unsigned short e[8];
#pragma unroll
            for (int i = 0; i < 8; ++i) { const int key = 16 * g + (i < 4 ? 4 * kgp + i : 8 + 4 * kgp + (i - 4)); e[i] = vl[key * 130 + d]; }
            u32x4 o; o.x = e[0] | ((unsigned)e[1] << 16); o.y = e[2] | ((unsigned)e[3] << 16); o.z = e[4] | ((unsigned)e[5] << 16); o.w = e[6] | ((unsigned)e[7] << 16);
            *(u32x4*)(Vt + ((size_t)bh * HD + d) * SEQ + n * 256 + ck * 8) = o; }
        __syncthreads();
    }
}

constexpr int AT_KROW = 272, AT_VROW = 144, AT_KBUF = 64 * AT_KROW, AT_VBUF = 128 * AT_VROW, AT_K0 = 0, AT_V0 = 2 * AT_KBUF, AT_KM = AT_V0 + 2 * AT_VBUF;
#define MFMA32(a, b, c) __builtin_amdgcn_mfma_f32_32x32x16_bf16((a), (b), (c), 0, 0, 0)
__device__ __forceinline__ bf16x8 pack8(float a0, float a1, float a2, float a3, float a4, float a5, float a6, float a7) {
    u32x4 p; p.x = pk2(a0, a1); p.y = pk2(a2, a3); p.z = pk2(a4, a5); p.w = pk2(a6, a7); return __builtin_bit_cast(bf16x8, p); }

__device__ __forceinline__ void attn_unit(int bh, int ob, const bf16* qraw, const float* qg, const bf16* Kn, const bf16* Vt, const float* kmean, bf16* O, LAS unsigned char* lds, int tid) {
    asm volatile("" : "+v"(tid));
    const int w = tid >> 6, lane = tid & 63, ql = lane & 31, hi = lane >> 5, b = bh >> 4, h = bh & 15;
    __syncthreads();
    ((LAS f32x4*)(lds + AT_KM))[tid] = ((const f32x4*)(kmean + (size_t)bh * 2048))[tid];
    __syncthreads();
    const int qi = 32 * w + ql;
    const int ntiles = 4 * (ob + 1);
    const bf16* Kbase = Kn + (size_t)bh * SEQ * HD;
    const bf16* Vbase = Vt + (size_t)bh * HD * SEQ;
    u32x4 pk0, pk1, pv0, pv1;
    auto prefetch = [&](int it) { const int s0 = (it >> 2) * 256 + (it & 3) * 64;
        const char* kp = (const char*)(Kbase + (size_t)s0 * HD); pk0 = *(const u32x4*)(kp + tid * 16); pk1 = *(const u32x4*)(kp + 8192 + tid * 16);
        const int d = tid >> 3, c = tid & 7; pv0 = *(const u32x4*)(Vbase + (size_t)d * SEQ + s0 + c * 8); pv1 = *(const u32x4*)(Vbase + (size_t)(d + 64) * SEQ + s0 + c * 8); };
    prefetch(0);
    const size_t tok = (size_t)b * SEQ + ob * 256 + qi;
    bf16x8 qb[8]; unsigned sel = 0;
    {
        const bf16* qp = qraw + tok * D + h * HD + 8 * hi;
        float qf[64]; float ss = 0.f;
#pragma unroll
        for (int s = 0; s < 8; ++s) {
            const u32x4 xw = *(const u32x4*)(qp + 16 * s);
            const float x[8] = {bflo(xw.x), bfhi(xw.x), bflo(xw.y), bfhi(xw.y), bflo(xw.z), bfhi(xw.z), bflo(xw.w), bfhi(xw.w)};
            const f32x4 g0 = *(const f32x4*)(qg + 16 * s + 8 * hi), g1 = *(const f32x4*)(qg + 16 * s + 8 * hi + 4);
#pragma unroll
            for (int i = 0; i < 4; ++i) { ss += x[i] * x[i] + x[4 + i] * x[4 + i]; qf[8 * s + i] = x[i] * g0[i]; qf[8 * s + 4 + i] = x[4 + i] * g1[i]; }
        }
        ss += __shfl_xor(ss, 32);
        const float rs = rsqrtf(ss * (1.0f / HD) + EPS) * (0.08838834764831845f * 1.4426950408889634f);
        if (ob > 0) {
            float gate[15];
            const LAS float* km = (const LAS float*)(lds + AT_KM) + 8 * hi;
#pragma unroll
            for (int n = 0; n < 15; ++n) {
                float acc = 0.f;
                if (n < ob) {
#pragma unroll
                    for (int s = 0; s < 8; ++s) { const f32x4 k0 = *(const LAS f32x4*)(km + n * 128 + 16 * s), k1 = *(const LAS f32x4*)(km + n * 128 + 16 * s + 4);
#pragma unroll
                        for (int i = 0; i < 4; ++i) { acc += qf[8 * s + i] * k0[i]; acc += qf[8 * s + 4 + i] * k1[i]; } }
                    acc += __shfl_xor(acc, 32);
                }
                gate[n] = acc;
            }
#pragma unroll
            for (int pick = 0; pick < 3; ++pick) if (pick < ob) {
                float best = -INFINITY; int bi = 0;
#pragma unroll
                for (int n = 0; n < 15; ++n) { const bool c = (n < ob) && !((sel >> n) & 1u) && (gate[n] > best); best = c ? gate[n] : best; bi = c ? n : bi; }
                sel |= 1u << bi;
            }
        }
#pragma unroll
        for (int s = 0; s < 8; ++s) qb[s] = pack8(qf[8 * s] * rs, qf[8 * s + 1] * rs, qf[8 * s + 2] * rs, qf[8 * s + 3] * rs, qf[8 * s + 4] * rs, qf[8 * s + 5] * rs, qf[8 * s + 6] * rs, qf[8 * s + 7] * rs);
    }
    f32x16 ot[4];
#pragma unroll
    for (int dt = 0; dt < 4; ++dt)
#pragma unroll
        for (int r = 0; r < 16; ++r) ot[dt][r] = 0.f;
    float mrun = -1e30f, lrun = 0.f;
    for (int it = 0; it < ntiles; ++it) {
        const int buf = it & 1;
        { LAS unsigned char* kb = lds + AT_K0 + buf * AT_KBUF; const int o0 = tid * 16, o1 = 8192 + tid * 16;
          *(LAS u32x4*)(kb + (o0 >> 8) * AT_KROW + (o0 & 255)) = pk0; *(LAS u32x4*)(kb + (o1 >> 8) * AT_KROW + (o1 & 255)) = pk1;
          LAS unsigned char* vb = lds + AT_V0 + buf * AT_VBUF; const int d = tid >> 3, c = tid & 7;
          *(LAS u32x4*)(vb + d * AT_VROW + c * 16) = pv0; *(LAS u32x4*)(vb + (d + 64) * AT_VROW + c * 16) = pv1; }
        __syncthreads();
        if (it + 1 < ntiles) prefetch(it + 1);
        const int nb = it >> 2, kt = it & 3;
        const bool own = (nb == ob);
        const bool lane_ok = own || ((sel >> nb) & 1u);
        const bool active = own ? (64 * kt <= 32 * w + 31) : (__ballot(lane_ok) != 0ull);
        if (active) {
            f32x16 st0, st1;
#pragma unroll
            for (int r = 0; r < 16; ++r) { st0[r] = 0.f; st1[r] = 0.f; }
            const LAS unsigned char* kb = lds + AT_K0 + buf * AT_KBUF + ql * AT_KROW + hi * 16;
#pragma unroll
            for (int s = 0; s < 8; ++s) { const bf16x8 k0 = *(const LAS bf16x8*)(kb + s * 32), k1 = *(const LAS bf16x8*)(kb + 32 * AT_KROW + s * 32);
                st0 = MFMA32(k0, qb[s], st0); st1 = MFMA32(k1, qb[s], st1); }
            if (own) {
                if (64 * kt + 63 > 32 * w) {
#pragma unroll
                    for (int r = 0; r < 16; ++r) { const int kk = 64 * kt + (r & 3) + 8 * (r >> 2) + 4 * hi;
                        st0[r] = (kk <= qi) ? st0[r] : -INFINITY; st1[r] = (kk + 32 <= qi) ? st1[r] : -INFINITY; }
                }
            }
            float mx = fmaxf(st0[0], st1[0]);
#pragma unroll
            for (int r = 1; r < 16; ++r) mx = fmaxf(mx, fmaxf(st0[r], st1[r]));
            mx = lane_ok ? mx : -INFINITY;
            mx = fmaxf(mx, __shfl_xor(mx, 32));
            const float mn = fmaxf(mrun, mx), alpha = __builtin_amdgcn_exp2f(mrun - mn);
            mrun = mn;
            const float msub = lane_ok ? mn : INFINITY;
            float ls = 0.f;
#pragma unroll
            for (int r = 0; r < 16; ++r) { st0[r] = __builtin_amdgcn_exp2f(st0[r] - msub); st1[r] = __builtin_amdgcn_exp2f(st1[r] - msub); ls += st0[r] + st1[r]; }
            lrun = lrun * alpha + ls;
            if (__ballot(alpha != 1.0f) != 0ull) {
#pragma unroll
                for (int dt = 0; dt < 4; ++dt)
#pragma unroll
                    for (int r = 0; r < 16; ++r) ot[dt][r] *= alpha;
            }
            const LAS unsigned char* vb = lds + AT_V0 + buf * AT_VBUF + ql * AT_VROW + hi * 16;
#pragma unroll
            for (int ks = 0; ks < 4; ++ks) {
                const int o = 8 * (ks & 1);
                const bf16x8 pf = (ks < 2) ? pack8(st0[o], st0[o + 1], st0[o + 2], st0[o + 3], st0[o + 4], st0[o + 5], st0[o + 6], st0[o + 7])
                                           : pack8(st1[o], st1[o + 1], st1[o + 2], st1[o + 3], st1[o + 4], st1[o + 5], st1[o + 6], st1[o + 7]);
#pragma unroll
                for (int dt = 0; dt < 4; ++dt) { const bf16x8 vf = *(const LAS bf16x8*)(vb + dt * 32 * AT_VROW + ks * 32); ot[dt] = MFMA32(vf, pf, ot[dt]); }
            }
        }
    }
    lrun += __shfl_xor(lrun, 32);
    const float inv = 1.0f / lrun;
    bf16* op = O + tok * D + h * HD + 4 * hi;
#pragma unroll
    for (int dt = 0; dt < 4; ++dt)
#pragma unroll
        for (int g4 = 0; g4 < 4; ++g4) { u32x2 o; o.x = pk2(ot[dt][4 * g4] * inv, ot[dt][4 * g4 + 1] * inv); o.y = pk2(ot[dt][4 * g4 + 2] * inv, ot[dt][4 * g4 + 3] * inv);
            *(u32x2*)(op + 32 * dt + 8 * g4) = o; }
}


#define XB_TMO      128
#define XB_XCNT(j)  (256  + 64 * (j))
#define XB_XSUB(j)  (1280 + 64 * (j))
#define XB_XGEN(j)  (2304 + 64 * (j))
#define XB_TOP      3328
#define XB_TOPGEN   3392
#define XCD_BAR_WORDS 3456
#define XB_SPIN_CAP (1u << 18)
__device__ __forceinline__ unsigned xb_ld(unsigned* p)              { return __hip_atomic_load(p, __ATOMIC_RELAXED, __HIP_MEMORY_SCOPE_AGENT); }
__device__ __forceinline__ unsigned xb_add(unsigned* p, unsigned v) { return __hip_atomic_fetch_add(p, v, __ATOMIC_RELAXED, __HIP_MEMORY_SCOPE_AGENT); }
__device__ __forceinline__ unsigned xb_xcc_id() { return (unsigned)__builtin_amdgcn_s_getreg((3 << 11) | 20) & 0xFu; }
#define XB_SPIN(cond, bar) do { unsigned _sp = 0; while (cond) { __builtin_amdgcn_s_sleep(1); \
    if ((++_sp & 255u) == 0u) { if (xb_ld(&(bar)[XB_TMO])) break; if (_sp > XB_SPIN_CAP) { atomicAdd(&(bar)[XB_TMO], 1u); break; } } } } while (0)
struct XcdBarrier { unsigned* bar; unsigned x; volatile LAS unsigned* st; };
__device__ __forceinline__ XcdBarrier xcd_barrier_post(unsigned* bar, volatile LAS unsigned* st) {
    XcdBarrier b; b.bar = bar; b.x = xb_xcc_id(); b.st = st;
    if (threadIdx.x == 0) (void)xb_add(&bar[XB_XCNT(b.x)], 1u);
    return b;
}
__device__ __forceinline__ void xcd_barrier_complete(unsigned* bar, unsigned x, unsigned& nloc, unsigned& nx) {
    const unsigned G = gridDim.x * gridDim.y * gridDim.z;
    unsigned sum, cnt, mine, sp = 0u;
    for (;;) {
        sum = 0u; cnt = 0u; mine = 0u;
#pragma unroll
        for (unsigned j = 0; j < 16; ++j) { const unsigned c = xb_ld(&bar[XB_XCNT(j)]); sum += c; cnt += (c > 0u) ? 1u : 0u; mine = (j == x) ? c : mine; }
        if (sum == G) break;
        __builtin_amdgcn_s_sleep(1);
        if ((++sp & 255u) == 0u) { if (xb_ld(&bar[XB_TMO])) break; if (sp > XB_SPIN_CAP) { atomicAdd(&bar[XB_TMO], 1u); break; } }
    }
    nloc = mine > 0u ? mine : 1u; nx = cnt > 0u ? cnt : 1u;
}
__device__ __forceinline__ void xcd_barrier(const XcdBarrier& b) {
    asm volatile("s_waitcnt vmcnt(0)" ::: "memory");
    __syncthreads();
    if (threadIdx.x == 0) {
        unsigned* bar = b.bar;
        __builtin_amdgcn_s_waitcnt(0);
        unsigned nloc = b.st[0], nx = b.st[1];
        if (nloc == 0u) { xcd_barrier_complete(bar, b.x, nloc, nx); b.st[0] = nloc; b.st[1] = nx; }
        const unsigned old = xb_add(&bar[XB_XSUB(b.x)], 1u);
        const unsigned gen = old / nloc;
        if (old + 1u == (gen + 1u) * nloc) {
            __builtin_amdgcn_fence(__ATOMIC_RELEASE, "agent");
            asm volatile("s_waitcnt vmcnt(0)" ::: "memory");
            const unsigned og = xb_add(&bar[XB_TOP], 1u);
            const unsigned tg = og / nx;
            if (og + 1u == (tg + 1u) * nx) xb_add(&bar[XB_TOPGEN], 1u);
            else XB_SPIN(xb_ld(&bar[XB_TOPGEN]) == tg, bar);
            __builtin_amdgcn_fence(__ATOMIC_ACQUIRE, "agent");
            xb_add(&bar[XB_XGEN(b.x)], 1u);
            asm volatile("s_waitcnt vmcnt(0)" ::: "memory");
        } else {
            XB_SPIN(xb_ld(&bar[XB_XGEN(b.x)]) == gen, bar);
            __builtin_amdgcn_fence(__ATOMIC_ACQUIRE, "agent");
            asm volatile("s_waitcnt vmcnt(0)" ::: "memory");
        }
    }
    __syncthreads();
}

__device__ __forceinline__ int opaque_(int v) { asm volatile("" : "+v"(v)); return v; }
__global__ void __launch_bounds__(512, 2) mega(Args A) {
    extern __shared__ __attribute__((aligned(16))) unsigned char lds_raw[];
    LAS unsigned char* lds = (LAS unsigned char*)lds_raw;
    cg::grid_group grid = cg::this_grid();
    const int tid = threadIdx.x;
#define lane (opaque_(tid) & 63)
#define wave __builtin_amdgcn_readfirstlane(opaque_(tid) >> 6)
#define gw ((int)blockIdx.x * 8 + wave)
#define gtid ((int)blockIdx.x * 512 + opaque_(tid))
    const int G = gridDim.x, NGW = G * 8, nthr = G * 512;
    unsigned char* ws = A.ws;
    bf16* ACT = (bf16*)(ws + WS_ACT);
    bf16* HB = (bf16*)(ws + WS_HN); pg8::u64* SS = (pg8::u64*)(ws + WS_SS);
    volatile LAS unsigned* xst = (volatile LAS unsigned*)(lds + LDS_BYTES - 16);
    if (tid < 4) xst[tid] = 0u;
    __syncthreads();
    XcdBarrier xbar = xcd_barrier_post((unsigned*)(ws + WS_BAR), xst);
#define SEAM() xcd_barrier(xbar)
#define GEMM(EpiT, Aop, Bop, N_, K_, lda_, amask, astr, ...) do { pg8::Gemm g{Aop, Bop, M, N_, K_, lda_, amask, astr}; pg8::StaticOrder S; S.init(M, N_, G, (int)blockIdx.x); \
        EpiT E{__VA_ARGS__}; pg8::gemm_phase<EpiT>(lds, g, S, E); } while (0)
#define SSB(k) (SS + (size_t)(k) * M)
#define IDLE_CONVERT(j) do { const bool half_ = (G == 256); if (!half_ || blockIdx.x >= 128) { const int gw_ = half_ ? ((int)blockIdx.x - 128) * 8 + wave : gw, ngw_ = half_ ? 128 * 8 : NGW; \
        p_convert(A, lds, 4 + (j), 5 + (j), gw_, ngw_, wave, lane); if ((j) < 3) p_convert(A, lds, (j) + 1, (j) + 2, gw_, ngw_, wave, lane); \
        if ((j) == 1) p_convert(A, lds, 11, 12, gw_, ngw_, wave, lane); if ((j) == 2) p_convert(A, lds, 12, 14, gw_, ngw_, wave, lane); } } while (0)
#define FFN_IN(j, ssin) GEMM(pg8::EpiSwiGLU, HB, (const bf16*)(ws + WS_WIN) + (size_t)(j) * 2 * FF * D, 2 * FF, D, D, 0, 0, ACT, ssin)
#define FFN_OUT(j, ssout, outp) GEMM(pg8::EpiResid, ACT, (const bf16*)(ws + WS_WOUT) + (size_t)(j) * D * FF, D, FF, FF, 0, 0, HB, ssout, outp, 0.5f)
    p_convert(A, lds, 0, 1, gw, NGW, wave, lane);
    p_convert(A, lds, 8, 11, gw, NGW, wave, lane);
    p_prep(A.in[0], HB, SSB(0), gw, NGW, lane);
    for (int c = gtid; c < D; c += nthr) { const float l = A.in[9][c]; ((float*)(ws + WS_C8))[c] = -8.0f * 1.4426950408889634f * (fmaxf(-l, 0.f) + log1pf(__expf(-fabsf(l)))); }
    for (int i = gtid; i < 5 * M; i += nthr) SS[M + i] = 0ull;
    if (A.ws == nullptr) grid.sync();
    SEAM();
    FFN_IN(0, SSB(0)); IDLE_CONVERT(0); SEAM();
    FFN_OUT(0, SSB(1), (float*)nullptr); SEAM();
    GEMM(pg8::EpiBf16, HB, (const bf16*)(ws + WS_WLIN), 2 * D, D, D, 0, 0, (bf16*)(ws + WS_XB), 4096, 8, SSB(1)); SEAM();
    { const int blk = (int)blockIdx.x;
        int t_ = tid; asm volatile("" : "+v"(t_));
        const int pm = blk >> 3, hh = blk & 7;
        conv_item((const bf16*)(ws + WS_XB), A.in[5], A.in[6], (bf16*)(ws + WS_XC), ((16 * pm + (t_ >> 5)) << 8) | (32 * hh + (t_ & 31)));
        asm volatile("s_waitcnt vmcnt(0)" ::: "memory"); __syncthreads();
        { pg8::Gemm g{(const bf16*)(ws + WS_XC), (const bf16*)(ws + WS_WG), M, 2 * D, 256, D, 7, 256}; pg8::PairOrder S{pm, hh}; pg8::EpiBf16 E{(bf16*)(ws + WS_GP), 4096, 1 << 30, (const pg8::u64*)nullptr};
          pg8::gemm_phase<pg8::EpiBf16, pg8::PairOrder>(lds, g, S, E); }
        asm volatile("s_waitcnt vmcnt(0)" ::: "memory"); __syncthreads();
        asm volatile("" : "+v"(t_));
        f32x4 pa, ha;
        scan_a_item((const bf16*)(ws + WS_GP), (const bf16*)(ws + WS_XC), A.in[8], (const float*)(ws + WS_C8), (float*)(ws + WS_SP), (float*)(ws + WS_SH), ((pm >> 4) << 16) | (((pm & 15) * 8 + (t_ >> 6)) << 9) | (64 * hh + (t_ & 63)), pa, ha);
        {
            LAS f32x4* agg = (LAS f32x4*)lds;
            agg[((t_ >> 6) * 64 + (t_ & 63)) * 2] = pa; agg[((t_ >> 6) * 64 + (t_ & 63)) * 2 + 1] = ha;
            __syncthreads();
            if ((t_ >> 6) == 0) { f32x4 P = {1.f, 1.f, 1.f, 1.f}, Hh = {0.f, 0.f, 0.f, 0.f};
#pragma unroll
                for (int j = 0; j < 8; ++j) { const f32x4 pj = agg[(j * 64 + t_) * 2], hj = agg[(j * 64 + t_) * 2 + 1]; Hh = pj * Hh + hj; P = P * pj; }
                const size_t o = (size_t)pm * D + 256 * hh + 4 * t_;
                *(f32x4*)((float*)(ws + WS_PP) + o) = P; *(f32x4*)((float*)(ws + WS_PH) + o) = Hh; }
        }
    }
    SEAM();
    p_scan_b((const bf16*)(ws + WS_GP), (const bf16*)(ws + WS_XC), A.in[8], (const float*)(ws + WS_C8), (const float*)(ws + WS_SP), (const float*)(ws + WS_SH), (const float*)(ws + WS_PP), (const float*)(ws + WS_PH), (const bf16*)(ws + WS_XB), (bf16*)(ws + WS_HY), gtid, nthr); SEAM();
    GEMM(pg8::EpiResid, (const bf16*)(ws + WS_HY), (const bf16*)(ws + WS_WLOUT), D, D, D, 0, 0, HB, SSB(2), (float*)nullptr, 1.0f); SEAM();
    FFN_IN(1, SSB(2)); IDLE_CONVERT(1); SEAM();
    FFN_OUT(1, SSB(3), (float*)nullptr); SEAM();
    GEMM(pg8::EpiBf16, HB, (const bf16*)(ws + WS_WKV), 2 * D, D, D, 0, 0, (bf16*)(ws + WS_KV), 4096, 1 << 30, SSB(3));
    FFN_IN(2, SSB(3)); IDLE_CONVERT(2); SEAM();
    p_knorm((const bf16*)(ws + WS_KV), A.in[13], (bf16*)(ws + WS_K), (bf16*)(ws + WS_VT), (float*)(ws + WS_KMEAN), lds, tid);
    FFN_OUT(2, SSB(4), (float*)nullptr); SEAM();
    GEMM(pg8::EpiBf16, HB, (const bf16*)(ws + WS_WQ), D, D, D, 0, 0, (bf16*)(ws + WS_Q), D, 1 << 30, SSB(4)); SEAM();
    for (int item = blockIdx.x; item < 256; item += G) { const int bh = item >> 3, sb = item & 7;
        attn_unit(bh, 15 - sb, (const bf16*)(ws + WS_Q), A.in[15], (const bf16*)(ws + WS_K), (const bf16*)(ws + WS_VT), (const float*)(ws + WS_KMEAN), (bf16*)(ws + WS_O), lds, tid);
        attn_unit(bh, sb, (const bf16*)(ws + WS_Q), A.in[15], (const bf16*)(ws + WS_K), (const bf16*)(ws + WS_VT), (const float*)(ws + WS_KMEAN), (bf16*)(ws + WS_O), lds, tid); }
    __syncthreads();
    SEAM();
    GEMM(pg8::EpiResid, (const bf16*)(ws + WS_O), (const bf16*)(ws + WS_WO), D, D, D, 0, 0, HB, SSB(5), (float*)nullptr, 1.0f); SEAM();
    FFN_IN(3, SSB(5)); IDLE_CONVERT(3); SEAM();
    FFN_OUT(3, (pg8::u64*)nullptr, A.out);
#undef SSB
#undef lane
#undef wave
#undef gw
#undef gtid
#undef IDLE_CONVERT
#undef SEAM
#undef GEMM
#undef FFN_IN
#undef FFN_OUT
}

extern "C" void kernel_launch(void* const* d_in, const int* in_sizes, int n_in, void* d_out, int out_size, void* d_ws, size_t ws_size, hipStream_t stream) {
    static int grid = 0;
    if (grid == 0) {
        if (n_in != 17 || out_size != M * D || ws_size < WS_END) { fprintf(stderr, "kernel_launch: unexpected shapes (n_in %d out %d ws %zu)\n", n_in, out_size, ws_size); grid = -1; return; }
        int dev = 0, cus = 0, per_cu = 0;
        hipGetDevice(&dev); hipDeviceGetAttribute(&cus, hipDeviceAttributeMultiprocessorCount, dev);
        if (hipFuncSetAttribute((const void*)mega, hipFuncAttributeMaxDynamicSharedMemorySize, LDS_BYTES) != hipSuccess) { fprintf(stderr, "kernel_launch: hipFuncSetAttribute failed\n"); grid = -1; return; }
        if (hipOccupancyMaxActiveBlocksPerMultiprocessor(&per_cu, (const void*)mega, 512, LDS_BYTES) != hipSuccess || per_cu < 1) { fprintf(stderr, "kernel_launch: occupancy query says %d\n", per_cu); per_cu = 1; }
        (void)hipGetLastError();
        grid = 256;
        if (cus * per_cu < 256) { fprintf(stderr, "kernel_launch: needs 256 co-resident workgroups, device offers %d\n", cus * per_cu); grid = -1; return; }
    }
    if (grid < 0) return;
    if (hipMemsetAsync((char*)d_ws + WS_BAR, 0, 16384, stream) != hipSuccess) { fprintf(stderr, "kernel_launch: memset failed\n"); return; }
    Args a{};
    for (int i = 0; i < 17; ++i) a.in[i] = (const float*)d_in[i];
    a.out = (float*)d_out; a.ws = (unsigned char*)d_ws;
    void* args[] = {&a};
    hipError_t e = hipLaunchCooperativeKernel((const void*)mega, dim3(grid), dim3(512), args, LDS_BYTES, stream);
    if (e != hipSuccess) fprintf(stderr, "cooperative launch failed: %s (grid %d)\n", hipGetErrorString(e), grid);
}
```
